# Optimizing an MI355X kernel written in HIP

```python
import math
import jax, jax.numpy as jnp
from jax import lax
import numpy as np

D_MODEL = 1024
BATCH = 2
SEQ = 16384
DEPTH = 4

CTX_LEN = 256
GRID_W = 64
HEAD_DIM = 64
ROPE_THETA = 10000.0
EPS = 1e-6
NEG_INF = -1e30

NA_HEADS = 8
NA_WIN_H = 8
NA_WIN_W = 16
DIFF_HEADS = 4
DIFF_QK_DIM = 64
DIFF_V_DIM = 128
DENSE_BLOCK = 128
SWA_Q_HEADS = 16
SWA_KV_HEADS = 4
SWA_WINDOW = 128
SWA_BLOCK = 128
PEER_HEADS = 8
PEER_NKEYS = 128
PEER_EXPERTS = PEER_NKEYS * PEER_NKEYS
PEER_QDIM = 256
PEER_TOPK = 16
PEER_CHUNK = 128

EVEN_IN = 3 * NA_HEADS * HEAD_DIM + DIFF_HEADS * (4 * DIFF_QK_DIM + DIFF_V_DIM)
EVEN_OUT = NA_HEADS * HEAD_DIM + DIFF_HEADS * DIFF_V_DIM
ODD_IN = (SWA_Q_HEADS + 2 * SWA_KV_HEADS) * HEAD_DIM
ODD_OUT = SWA_Q_HEADS * HEAD_DIM
N_EVEN = (DEPTH + 1) // 2
N_ODD = DEPTH // 2

kernel_name = "hybrid_natten_diff_swa_peer_dit"


def rmsnorm(x, g):
    xf = x.astype(jnp.float32)
    y = xf * lax.rsqrt(jnp.mean(xf * xf, axis=-1, keepdims=True) + EPS)
    return (y * g.astype(jnp.float32)).astype(x.dtype)


def split_mod(m, lead):
    m = m.reshape(lead + (6, D_MODEL))
    return tuple(m[..., k, :] for k in range(6))


def rope_tables(n_tokens):
    t = jnp.arange(n_tokens)
    row = (t // GRID_W).astype(jnp.float32)
    col = (t % GRID_W).astype(jnp.float32)
    half = HEAD_DIM // 2
    inv = ROPE_THETA ** (-jnp.arange(0, half, 2, dtype=jnp.float32) / half)
    ar = row[:, None] * inv
    ac = col[:, None] * inv
    ang = jnp.concatenate([ar, ar, ac, ac], axis=-1)
    return jnp.cos(ang), jnp.sin(ang)


def apply_rope2d(x, cos, sin):
    q = HEAD_DIM // 4
    rot = jnp.concatenate([-x[..., q:2 * q], x[..., :q], -x[..., 3 * q:], x[..., 2 * q:3 * q]], axis=-1)
    shp = (x.shape[1],) + (1,) * (x.ndim - 3) + (HEAD_DIM,)
    return (x * cos.reshape(shp) + rot * sin.reshape(shp)).astype(x.dtype)


def plain_ctx_attention(qc, kc, vc):
    B, C, H, d = qc.shape
    s = jnp.einsum('bqhd,bkhd->bhqk', qc, kc).astype(jnp.float32) * (d ** -0.5)
    p = jax.nn.softmax(s, axis=-1).astype(vc.dtype)
    return jnp.einsum('bhqk,bkhd->bqhd', p, vc).reshape(B, C, H * d)


def neighborhood_attention(q, k, v, qc, kc, vc, rpb, need_ctx):
    B, S, H, d = q.shape
    rows = S // GRID_W
    kh = min(NA_WIN_H, rows)
    kw = NA_WIN_W
    scale = d ** -0.5
    qg = q.reshape(B, rows, GRID_W, H, d)
    kg = k.reshape(B, rows, GRID_W, H, d)
    vg = v.reshape(B, rows, GRID_W, H, d)
    cols = jnp.arange(GRID_W)
    col_start = jnp.clip(cols - kw // 2, 0, GRID_W - kw)
    col_idx = col_start[:, None] + jnp.arange(kw)
    dc = col_idx - cols[:, None] + (NA_WIN_W - 1)
    rpb_c = rpb[:, :, dc]

    def one_row(args):
        r, q_row = args
        rs = jnp.clip(r - kh // 2, 0, rows - kh)
        k_rows = lax.dynamic_slice_in_dim(kg, rs, kh, axis=1)
        v_rows = lax.dynamic_slice_in_dim(vg, rs, kh, axis=1)
        k_nb = k_rows[:, :, col_idx]
        v_nb = v_rows[:, :, col_idx]
        dr = rs + jnp.arange(kh) - r + (NA_WIN_H - 1)
        bias = rpb_c[:, dr].transpose(0, 2, 1, 3)
        s_nb = jnp.einsum('bqhd,brqwhd->bhqrw', q_row, k_nb).astype(jnp.float32) * scale
        s_nb = (s_nb + bias[None].astype(jnp.float32)).reshape(B, H, GRID_W, kh * kw)
        s_ctx = jnp.einsum('bqhd,bchd->bhqc', q_row, kc).astype(jnp.float32) * scale
        p = jax.nn.softmax(jnp.concatenate([s_nb, s_ctx], axis=-1), axis=-1).astype(v.dtype)
        p_nb = p[..., :kh * kw].reshape(B, H, GRID_W, kh, kw)
        p_ctx = p[..., kh * kw:]
        return (jnp.einsum('bhqrw,brqwhd->bqhd', p_nb, v_nb)
                + jnp.einsum('bhqc,bchd->bqhd', p_ctx, vc))

    out = lax.map(one_row, (jnp.arange(rows), qg.transpose(1, 0, 2, 3, 4)))
    out = out.transpose(1, 0, 2, 3, 4).reshape(B, S, H * d)
    out_c = plain_ctx_attention(qc, kc, vc) if need_ctx else None
    return out, out_c


def diff_attention(q, k, v, qc, kc, vc, lam_p, subln_g, lam_init, need_ctx):
    B, S, H, _, dq = q.shape
    dv = v.shape[-1]
    scale = dq ** -0.5
    lp = lam_p.astype(jnp.float32)
    lam = jnp.exp(jnp.sum(lp[0] * lp[1])) - jnp.exp(jnp.sum(lp[2] * lp[3])) + lam_init

    def attend(qb, kk, vv):
        s = jnp.einsum('bqhmd,bkhmd->bmhqk', qb, kk).astype(jnp.float32) * scale
        p = jax.nn.softmax(s, axis=-1)
        pd = (p[:, 0] - lam * p[:, 1]).astype(vv.dtype)
        o = jnp.einsum('bhqk,bkhd->bqhd', pd, vv)
        return (rmsnorm(o, subln_g) * (1.0 - lam_init)).astype(vv.dtype)

    k_all = jnp.concatenate([kc, k], axis=1)
    v_all = jnp.concatenate([vc, v], axis=1)
    nb = S // DENSE_BLOCK
    qblocks = q.reshape(B, nb, DENSE_BLOCK, H, 2, dq).transpose(1, 0, 2, 3, 4, 5)
    out = lax.map(lambda qb: attend(qb, k_all, v_all), qblocks)
    out = out.transpose(1, 0, 2, 3, 4).reshape(B, S, H * dv)
    out_c = attend(qc, kc, vc).reshape(B, qc.shape[1], H * dv) if need_ctx else None
    return out, out_c


def window_gqa(q, k, v, qc, kc, vc, sink, need_ctx):
    B, S, Hq, d = q.shape
    Hkv = k.shape[2]
    G = Hq // Hkv
    scale = d ** -0.5
    blk = SWA_BLOCK
    nb = S // blk
    pad = ((0, 0), (blk, blk), (0, 0), (0, 0))
    kp = jnp.pad(k, pad)
    vp = jnp.pad(v, pad)
    qi = jnp.arange(blk)
    kj = jnp.arange(3 * blk)
    band = jnp.abs(kj[None, :] - blk - qi[:, None]) <= SWA_WINDOW
    sink_f = sink.astype(jnp.float32).reshape(Hkv, G)

    def sink_attend(qg, s_parts, v_parts):
        n = qg.shape[1]
        s_sink = jnp.broadcast_to(sink_f[None, :, :, None, None], (B, Hkv, G, n, 1))
        p = jax.nn.softmax(jnp.concatenate([s_sink] + s_parts, axis=-1), axis=-1)
        o = 0.0
        off = 1
        for s_i, v_i in zip(s_parts, v_parts):
            w = s_i.shape[-1]
            o = o + jnp.einsum('bngqj,bjnd->bqngd', p[..., off:off + w].astype(v_i.dtype), v_i)
            off += w
        return o.reshape(B, n, Hq * d).astype(v_parts[0].dtype)

    def one_block(args):
        bi, qb = args
        start = bi * blk
        kb = lax.dynamic_slice_in_dim(kp, start, 3 * blk, axis=1)
        vb = lax.dynamic_slice_in_dim(vp, start, 3 * blk, axis=1)
        kpos = start - blk + kj
        valid = band & ((kpos >= 0) & (kpos < S))[None, :]
        qg = qb.reshape(B, blk, Hkv, G, d)
        s_loc = jnp.einsum('bqngd,bjnd->bngqj', qg, kb).astype(jnp.float32) * scale
        s_loc = jnp.where(valid, s_loc, NEG_INF)
        s_ctx = jnp.einsum('bqngd,bjnd->bngqj', qg, kc).astype(jnp.float32) * scale
        return sink_attend(qg, [s_loc, s_ctx], [vb, vc])

    qblocks = q.reshape(B, nb, blk, Hq, d).transpose(1, 0, 2, 3, 4)
    out = lax.map(one_block, (jnp.arange(nb), qblocks))
    out = out.transpose(1, 0, 2, 3).reshape(B, S, Hq * d)
    out_c = None
    if need_ctx:
        qcg = qc.reshape(B, qc.shape[1], Hkv, G, d)
        s_c = jnp.einsum('bqngd,bjnd->bngqj', qcg, kc).astype(jnp.float32) * scale
        out_c = sink_attend(qcg, [s_c], [vc])
    return out, out_c


def even_mixer(hx, hc, w_in, w_out, rpb, lam_p, subln_g, cos, sin, lam_init, need_ctx):
    B, S, _ = hx.shape
    a = NA_HEADS * HEAD_DIM
    bqk = DIFF_HEADS * 2 * DIFF_QK_DIM

    def split(p, n):
        qa = p[..., :a].reshape(B, n, NA_HEADS, HEAD_DIM)
        ka = p[..., a:2 * a].reshape(B, n, NA_HEADS, HEAD_DIM)
        va = p[..., 2 * a:3 * a].reshape(B, n, NA_HEADS, HEAD_DIM)
        o = 3 * a
        qb = p[..., o:o + bqk].reshape(B, n, DIFF_HEADS, 2, DIFF_QK_DIM)
        kb = p[..., o + bqk:o + 2 * bqk].reshape(B, n, DIFF_HEADS, 2, DIFF_QK_DIM)
        vb = p[..., o + 2 * bqk:].reshape(B, n, DIFF_HEADS, DIFF_V_DIM)
        return qa, ka, va, qb, kb, vb

    qa, ka, va, qb, kb, vb = split(hx @ w_in, S)
    qac, kac, vac, qbc, kbc, vbc = split(hc @ w_in, hc.shape[1])
    qb = apply_rope2d(qb, cos, sin)
    kb = apply_rope2d(kb, cos, sin)
    oa, oac = neighborhood_attention(qa, ka, va, qac, kac, vac, rpb, need_ctx)
    ob, obc = diff_attention(qb, kb, vb, qbc, kbc, vbc, lam_p, subln_g, lam_init, need_ctx)
    y = jnp.concatenate([oa, ob], axis=-1) @ w_out
    yc = jnp.concatenate([oac, obc], axis=-1) @ w_out if need_ctx else None
    return y, yc


def odd_mixer(hx, hc, w_in, w_out, sink, cos, sin, need_ctx):
    B, S, _ = hx.shape
    nq = SWA_Q_HEADS * HEAD_DIM
    nkv = SWA_KV_HEADS * HEAD_DIM

    def split(p, n):
        return (p[..., :nq].reshape(B, n, SWA_Q_HEADS, HEAD_DIM),
                p[..., nq:nq + nkv].reshape(B, n, SWA_KV_HEADS, HEAD_DIM),
                p[..., nq + nkv:].reshape(B, n, SWA_KV_HEADS, HEAD_DIM))

    q, k, v = split(hx @ w_in, S)
    qc, kc, vc = split(hc @ w_in, hc.shape[1])
    q = apply_rope2d(q, cos, sin)
    k = apply_rope2d(k, cos, sin)
    o, oc = window_gqa(q, k, v, qc, kc, vc, sink, need_ctx)
    y = o @ w_out
    yc = oc @ w_out if need_ctx else None
    return y, yc


def peer(h, w_q, sub_keys, u, v):
    T, D = h.shape
    q = (h @ w_q).reshape(T, PEER_HEADS, 2, PEER_QDIM // 2)
    s = jnp.einsum('thpd,hpnd->thpn', q, sub_keys).astype(jnp.float32)
    sv, si = lax.top_k(s, PEER_TOPK)
    cand = (sv[:, :, 0, :, None] + sv[:, :, 1, None, :]).reshape(T, PEER_HEADS, PEER_TOPK * PEER_TOPK)
    fv, fi = lax.top_k(cand, PEER_TOPK)
    i1 = jnp.take_along_axis(si[:, :, 0], fi // PEER_TOPK, axis=-1)
    i2 = jnp.take_along_axis(si[:, :, 1], fi % PEER_TOPK, axis=-1)
    idx = (i1 * PEER_NKEYS + i2).reshape(T, PEER_HEADS * PEER_TOPK)
    g = jax.nn.softmax(fv, axis=-1).reshape(T, PEER_HEADS * PEER_TOPK).astype(h.dtype)
    nc = T // PEER_CHUNK

    def chunk(args):
        hc, ic, gc = args
        ue = u[ic]
        ve = v[ic]
        act = jax.nn.gelu(jnp.einsum('td,ted->te', hc, ue), approximate=False)
        return jnp.einsum('te,ted->td', gc * act, ve)

    out = lax.map(chunk, (h.reshape(nc, PEER_CHUNK, D),
                          idx.reshape(nc, PEER_CHUNK, -1),
                          g.reshape(nc, PEER_CHUNK, -1)))
    return out.reshape(T, D)


def setup_inputs(seed: int = 0) -> dict:
    key = jax.random.key(seed)
    ks = jax.random.split(key, 24)
    D = D_MODEL

    def nrm(k, shape, s):
        return jax.random.normal(k, shape, jnp.float32) * s

    return {
        "x": nrm(ks[0], (BATCH, SEQ, D), 1.0),
        "c": nrm(ks[1], (BATCH, D), 1.0),
        "ctx": nrm(ks[2], (BATCH, CTX_LEN, D), 1.0),
        "c_ctx": nrm(ks[3], (D,), 1.0),
        "w_mod": nrm(ks[4], (DEPTH, D, 6 * D), 0.5 * D ** -0.5),
        "b_mod": nrm(ks[5], (DEPTH, 6 * D), 0.02),
        "norm1_g": 1.0 + nrm(ks[6], (DEPTH, D), 0.05),
        "norm2_g": 1.0 + nrm(ks[7], (DEPTH, D), 0.05),
        "w_in_even": nrm(ks[8], (N_EVEN, D, EVEN_IN), D ** -0.5),
        "w_out_even": nrm(ks[9], (N_EVEN, EVEN_OUT, D), EVEN_OUT ** -0.5),
        "na_rpb": nrm(ks[10], (N_EVEN, NA_HEADS, 2 * NA_WIN_H - 1, 2 * NA_WIN_W - 1), 0.1),
        "diff_lambda": nrm(ks[11], (N_EVEN, 4, DIFF_QK_DIM), 0.1),
        "diff_subln_g": 1.0 + nrm(ks[12], (N_EVEN, DIFF_V_DIM), 0.05),
        "w_in_odd": nrm(ks[13], (N_ODD, D, ODD_IN), D ** -0.5),
        "w_out_odd": nrm(ks[14], (N_ODD, ODD_OUT, D), ODD_OUT ** -0.5),
        "swa_sink": nrm(ks[15], (N_ODD, SWA_Q_HEADS), 0.5),
        "peer_wq": nrm(ks[16], (DEPTH, D, PEER_HEADS * PEER_QDIM), D ** -0.5),
        "peer_keys": nrm(ks[17], (DEPTH, PEER_HEADS, 2, PEER_NKEYS, PEER_QDIM // 2), (PEER_QDIM // 2) ** -0.5),
        "peer_u": nrm(ks[18], (DEPTH, PEER_EXPERTS, D), D ** -0.5),
        "peer_v": nrm(ks[19], (DEPTH, PEER_EXPERTS, D), 0.25),
        "final_g": 1.0 + nrm(ks[20], (D,), 0.05),
    }


def reference(x, c, ctx, c_ctx, w_mod, b_mod, norm1_g, norm2_g, w_in_even, w_out_even,
              na_rpb, diff_lambda, diff_subln_g, w_in_odd, w_out_odd, swa_sink,
              peer_wq, peer_keys, peer_u, peer_v, final_g):
    B, S, D = x.shape
    C = ctx.shape[1]
    cos, sin = rope_tables(S)
    sc = jax.nn.silu(c)
    scc = jax.nn.silu(c_ctx)
    for i in range(DEPTH):
        need_ctx = i < DEPTH - 1
        sh1, sc1, g1, sh2, sc2, g2 = split_mod(sc @ w_mod[i] + b_mod[i], (B, 1))
        ch1, cc1, cg1, ch2, cc2, cg2 = split_mod(scc @ w_mod[i] + b_mod[i], (1, 1))
        hx = rmsnorm(x, norm1_g[i]) * (1.0 + sc1) + sh1
        hc = rmsnorm(ctx, norm1_g[i]) * (1.0 + cc1) + ch1
        if i % 2 == 0:
            j = i // 2
            lam_init = 0.8 - 0.6 * math.exp(-0.3 * i)
            y, yc = even_mixer(hx, hc, w_in_even[j], w_out_even[j], na_rpb[j], diff_lambda[j],
                               diff_subln_g[j], cos, sin, lam_init, need_ctx)
        else:
            j = i // 2
            y, yc = odd_mixer(hx, hc, w_in_odd[j], w_out_odd[j], swa_sink[j], cos, sin, need_ctx)
        x = x + g1 * y
        hx = rmsnorm(x, norm2_g[i]) * (1.0 + sc2) + sh2
        if need_ctx:
            ctx = ctx + cg1 * yc
            hc = rmsnorm(ctx, norm2_g[i]) * (1.0 + cc2) + ch2
            tokens = jnp.concatenate([hx.reshape(B * S, D), hc.reshape(B * C, D)], axis=0)
            f = peer(tokens, peer_wq[i], peer_keys[i], peer_u[i], peer_v[i])
            x = x + g2 * f[:B * S].reshape(B, S, D)
            ctx = ctx + cg2 * f[B * S:].reshape(B, C, D)
        else:
            f = peer(hx.reshape(B * S, D), peer_wq[i], peer_keys[i], peer_u[i], peer_v[i])
            x = x + g2 * f.reshape(B, S, D)
    return rmsnorm(x, final_g)
```

```cpp
#define MK_KINDS 0x3FF
#define MK_SKIP 0
#define MK_PER_PHASE 0
#include <hip/hip_runtime.h>
#include <hip/hip_bf16.h>
#include <cstdio>
#include <cstdint>
#include <cmath>
namespace pg8 {
#define PG8_LAS __attribute__((address_space(3)))
typedef unsigned short bf16_t;
typedef short bf16x8 __attribute__((ext_vector_type(8)));
typedef float f32x4 __attribute__((ext_vector_type(4)));
typedef unsigned u32x4 __attribute__((ext_vector_type(4)));
constexpr int BM = 256, BK = 64, HALF = 128, HTB = HALF * BK * 2  , STAGE_BYTES = 8 * HTB, NXCD = 8, WGM = 8;

__host__ __device__ __forceinline__ int lds_byte(int r, int c) { const int st = (r >> 4) * 2 + (c >> 5), rr = r & 15, cc = c & 31, ob = rr * 64 + cc * 2; return st * 1024 + (ob ^ (((ob >> 9) & 1) << 5)); }
__host__ __device__ __forceinline__ void stage_rc(int b, int& R, int& C) { const int st = b / 1024, sb = b % 1024, swz = sb ^ (((sb >> 9) & 1) << 5); R = (st >> 1) * 16 + swz / 64; C = (st & 1) * 32 + (swz % 64) / 2; }
__host__ __device__ __forceinline__ int perm32(int rho) { const int n = rho >> 4, i = rho & 15; return 8 * (i >> 2) + 4 * n + (i & 3); }

struct Unit { int pm, pn; };
struct Gemm { const bf16_t* A; const bf16_t* Bt; int M, N, K; };

struct StaticOrder {
    int nM, nN, nwg, G, c;
    __host__ __device__ void init(int M, int N, int G_, int c_) { nM = M / BM; nN = N / BM; nwg = nM * nN; G = G_; c = c_; }
    __host__ __device__ bool next(int i, Unit& u) const {
        const long L = (long)i * G + c; if (L >= nwg) return false;
        int wgid = (int)L; { const int q = nwg / NXCD, r = nwg % NXCD, xcd = wgid % NXCD, off = wgid / NXCD; wgid = (xcd < r ? xcd * (q + 1) : r * (q + 1) + (xcd - r) * q) + off; }
        const int nig = WGM * nN, gid = wgid / nig, fm = gid * WGM, gsz = (nM - fm) < WGM ? (nM - fm) : WGM;
        u.pm = fm + ((wgid % nig) % gsz); u.pn = (wgid % nig) / gsz; return true;
    }
    __device__ __forceinline__ void a_ready(const Unit&) const {}
    __device__ __forceinline__ void done(const Unit&) const {}
};

__device__ __forceinline__ unsigned cvt_pk_bf16(float lo, float hi) { unsigned r; asm volatile("v_cvt_pk_bf16_f32 %0, %1, %2" : "=v"(r) : "v"(lo), "v"(hi)); return r; }
typedef float f32x2 __attribute__((ext_vector_type(2)));
struct EpiProj {
    static constexpr bool PERM = true, AFTER_DRAIN = false;
    bf16_t* O; int ldc; int mode; const float* rope; float qscale;
    __device__ __forceinline__ void operator()(const f32x4 (&acc)[2][2][4][2], const Unit& u, int wr, int wc, int fr, int fq) const {
        const int pn = u.pn;
        bool isq = false, isrope = false;
        if (mode == 0) { isq = (pn < 2) || (pn == 6) || (pn == 7); isrope = (pn >= 6) && (pn <= 9); }
        else if (mode == 1) { isq = pn < 4; isrope = pn < 5; }
        isrope = isrope && (u.pm < 128);
        const float sc = isq ? qscale : 1.f;
        const int row0 = u.pm * BM + wr * 64 + fr, col0 = u.pn * BM + wc * 32 + 8 * fq;
        const float sgn = (fq & 2) ? 1.f : -1.f;
#pragma unroll
        for (int ai = 0; ai < 2; ++ai)
#pragma unroll
            for (int m = 0; m < 4; ++m) {
                const int row = row0 + ai * HALF + m * 16;
                bf16_t* rowp = O + (size_t)row * ldc + col0;
                f32x4 cs[4];
                if (isrope) {
                    const int t = row & 16383; const int pos = (wc & 1) ? 256 + (t & 63) : (t >> 6);
                    const f32x4* rp = (const f32x4*)(rope + (size_t)(pos * 16 + 8 * (fq & 1)) * 2);
                    cs[0] = rp[0]; cs[1] = rp[1]; cs[2] = rp[2]; cs[3] = rp[3];
                }
#pragma unroll
                for (int bj = 0; bj < 2; ++bj) {
                    f32x4 v0 = acc[ai][bj][m][0], v1 = acc[ai][bj][m][1];
                    if (isrope) {
                        float x[8] = {v0[0], v0[1], v0[2], v0[3], v1[0], v1[1], v1[2], v1[3]};
#pragma unroll
                        for (int j = 0; j < 8; ++j) {
                            const float pr = __shfl_xor(x[j], 32);
                            const float c = cs[j >> 1][(j & 1) * 2], s = cs[j >> 1][(j & 1) * 2 + 1];
                            x[j] = x[j] * c + sgn * pr * s;
                        }
                        v0 = (f32x4){x[0], x[1], x[2], x[3]}; v1 = (f32x4){x[4], x[5], x[6], x[7]};
                    }
                    v0 = v0 * sc; v1 = v1 * sc;
                    u32x4 w; w.x = cvt_pk_bf16(v0[0], v0[1]); w.y = cvt_pk_bf16(v0[2], v0[3]); w.z = cvt_pk_bf16(v1[0], v1[1]); w.w = cvt_pk_bf16(v1[2], v1[3]);
                    *(u32x4*)(rowp + bj * HALF) = w;
                }
            }
    }
};
struct EpiResid {
    static constexpr bool PERM = false, AFTER_DRAIN = false;
    const float* base_lat; const float* base_ctx; float* out; const float* gate;
    __device__ __forceinline__ void operator()(const f32x4 (&acc)[2][2][4][2], const Unit& u, int wr, int wc, int fr, int fq) const {
        const int row0 = u.pm * BM + wr * 64 + fr, col0 = u.pn * BM + wc * 32 + 4 * fq;
        const bool lat = u.pm < 128;
        const int mrow = lat ? (u.pm >> 6) : 2;
        const float* gp = gate + (size_t)mrow * 6144 + col0;
        f32x4 gv[2][2];
#pragma unroll
        for (int bj = 0; bj < 2; ++bj)
#pragma unroll
            for (int n = 0; n < 2; ++n) gv[bj][n] = *(const f32x4*)(gp + bj * HALF + n * 16);
#pragma unroll
        for (int ai = 0; ai < 2; ++ai)
#pragma unroll
            for (int m = 0; m < 4; ++m) {
                const int row = row0 + ai * HALF + m * 16;
                const float* bp = lat ? base_lat + (size_t)row * 1024 + col0 : base_ctx + (size_t)(row - 32768) * 1024 + col0;
                float* op = out + (size_t)row * 1024 + col0;
#pragma unroll
                for (int bj = 0; bj < 2; ++bj)
#pragma unroll
                    for (int n = 0; n < 2; ++n) { const f32x4 b = *(const f32x4*)(bp + bj * HALF + n * 16); *(f32x4*)(op + bj * HALF + n * 16) = b + gv[bj][n] * acc[ai][bj][m][n]; }
            }
    }
};
template <class Epi, class Sched, bool ALIGN_EPI = false, bool SP2 = false>
__device__ __forceinline__ void gemm_phase(PG8_LAS unsigned char* lds, const Gemm g, const Sched& S, const Epi& E) {
    int tid = threadIdx.x; asm volatile("" : "+v"(tid));
    const int wid = __builtin_amdgcn_readfirstlane(tid >> 6), lane = tid & 63, wr = wid >> 2, wc = wid & 3, fr = lane & 15, fq = lane >> 4;
    const int K = g.K, nt = K / BK;
    unsigned voffA[2], voffB[2];
#pragma unroll
    for (int i = 0; i < 2; ++i) { int R, C; stage_rc(tid * 16 + i * 8192, R, C); const int Rb = Epi::PERM ? ((R & ~31) + perm32(R & 31)) : R;
        voffA[i] = (unsigned)(R * K + C) * 2u; voffB[i] = (unsigned)(Rb * K + C) * 2u; }
    const size_t kstep = (size_t)(BK * 2);
    const size_t hstep = (size_t)HALF * K * 2;
    const size_t tstep = 2 * hstep;
    const unsigned ldsw = (unsigned)wid * 1024u;
    const int aoff = lds_byte(wr * 64 + fr, fq * 8), boff = lds_byte(wc * 32 + fr, fq * 8);
#define PG8_SA(b, h) (((b) * 2 + (h)) * HTB)
#define PG8_SB(b, h) ((4 + (b) * 2 + (h)) * HTB)
#define PG8_STAGE(bufoff, gbase, voff) do { _Pragma("unroll") for (int _i = 0; _i < 2; ++_i) \
        __builtin_amdgcn_global_load_lds((const unsigned*)((const char*)(gbase) + (voff)[_i]), (PG8_LAS unsigned*)(lds + (bufoff) + ldsw + _i * 8192), 16, 0, 0); } while (0)
#define PG8_LDA(dst, b, h) do { _Pragma("unroll") for (int m = 0; m < 4; ++m) _Pragma("unroll") for (int k = 0; k < 2; ++k) dst[m][k] = *(const PG8_LAS bf16x8*)(lds + PG8_SA(b, h) + aoff + m * 2048 + k * 1024); } while (0)
#define PG8_LDB(dst, b, h) do { _Pragma("unroll") for (int n = 0; n < 2; ++n) _Pragma("unroll") for (int k = 0; k < 2; ++k) dst[n][k] = *(const PG8_LAS bf16x8*)(lds + PG8_SB(b, h) + boff + n * 2048 + k * 1024); } while (0)
#define PG8_MMA(ai, bj, At, Bt) do { __builtin_amdgcn_s_setprio(1); _Pragma("unroll") for (int m = 0; m < 4; ++m) _Pragma("unroll") for (int n = 0; n < 2; ++n) _Pragma("unroll") for (int k = 0; k < 2; ++k) \
        acc[ai][bj][m][n] = __builtin_amdgcn_mfma_f32_16x16x32_bf16(Bt[n][k], At[m][k], acc[ai][bj][m][n], 0, 0, 0); __builtin_amdgcn_s_setprio(0); } while (0)
#define PG8_WAIT_V(n) asm volatile("s_waitcnt vmcnt(" #n ")" ::: "memory")
#define PG8_WAIT_L(n) asm volatile("s_waitcnt lgkmcnt(" #n ")" ::: "memory")
#define PG8_BAR __builtin_amdgcn_s_barrier()
#define PG8_SCHED __builtin_amdgcn_sched_barrier(0)
    Unit cur, nxt; int ui = 0;
    if (!S.next(0, cur)) return;
    f32x4 acc[2][2][4][2];
#pragma unroll
    for (int a = 0; a < 2; ++a)
#pragma unroll
        for (int b = 0; b < 2; ++b)
#pragma unroll
            for (int m = 0; m < 4; ++m)
#pragma unroll
                for (int n = 0; n < 2; ++n) acc[a][b][m][n] = (f32x4){0.f, 0.f, 0.f, 0.f};
    bf16x8 At[4][2], B0[2][2], B1[2][2];
    const char* cA = (const char*)g.A + (size_t)cur.pm * tstep; const char* cB = (const char*)g.Bt + (size_t)cur.pn * tstep;
    S.a_ready(cur);
    if constexpr (SP2) {
        PG8_STAGE(PG8_SB(0, 0), cB, voffB); PG8_STAGE(PG8_SB(0, 1), cB + hstep, voffB); PG8_STAGE(PG8_SA(0, 0), cA, voffA); PG8_STAGE(PG8_SA(0, 1), cA + hstep, voffA);
        if (wr == 1) PG8_BAR;
        PG8_WAIT_V(2); PG8_BAR;
        PG8_STAGE(PG8_SB(1, 0), cB + kstep, voffB); PG8_STAGE(PG8_SA(1, 0), cA + kstep, voffA); PG8_STAGE(PG8_SB(1, 1), cB + hstep + kstep, voffB);
        PG8_WAIT_V(6); PG8_BAR;
    } else {
        PG8_STAGE(PG8_SB(0, 0), cB, voffB); PG8_STAGE(PG8_SA(0, 0), cA, voffA); PG8_STAGE(PG8_SB(0, 1), cB + hstep, voffB); PG8_STAGE(PG8_SA(0, 1), cA + hstep, voffA);
        if (wr == 1) PG8_BAR;
        PG8_WAIT_V(4); PG8_BAR;
        PG8_STAGE(PG8_SB(1, 0), cB + kstep, voffB); PG8_STAGE(PG8_SA(1, 0), cA + kstep, voffA); PG8_STAGE(PG8_SB(1, 1), cB + hstep + kstep, voffB);
        PG8_WAIT_V(6); PG8_BAR;
    }
    for (;;) {
        const bool has_next = S.next(ui + 1, nxt);
        const char* nA = has_next ? (const char*)g.A + (size_t)nxt.pm * tstep : cA; const char* nB = has_next ? (const char*)g.Bt + (size_t)nxt.pn * tstep : cB;
        for (int t = 0; t < nt; t += 2) {
            const bool last = (t == nt - 2);
            const char* a1 = cA + (size_t)(t + 1) * kstep;
            const char* a2 = last ? nA : cA + (size_t)(t + 2) * kstep; const char* b2 = last ? nB : cB + (size_t)(t + 2) * kstep;
            const char* a3 = a2 + kstep; const char* b3 = b2 + kstep;
            if (last && has_next) S.a_ready(nxt);
            if constexpr (SP2) {
            PG8_LDB(B0, 0, 0); PG8_LDB(B1, 0, 1); PG8_SCHED; PG8_LDA(At, 0, 0); PG8_STAGE(PG8_SA(1, 1), a1 + hstep, voffA);
            PG8_WAIT_V(8); PG8_WAIT_L(0); PG8_BAR; PG8_MMA(0, 0, At, B0); PG8_MMA(0, 1, At, B1); PG8_BAR; PG8_SCHED;
            PG8_LDA(At, 0, 1); PG8_STAGE(PG8_SB(0, 0), b2, voffB); PG8_STAGE(PG8_SB(0, 1), b2 + hstep, voffB); PG8_STAGE(PG8_SA(0, 0), a2, voffA);
            PG8_WAIT_V(8); PG8_WAIT_L(0); PG8_BAR; PG8_MMA(1, 0, At, B0); PG8_MMA(1, 1, At, B1); PG8_BAR; PG8_SCHED;
            PG8_LDB(B0, 1, 0); PG8_LDB(B1, 1, 1); PG8_SCHED; PG8_LDA(At, 1, 0); PG8_STAGE(PG8_SA(0, 1), a2 + hstep, voffA);
            PG8_WAIT_V(8); PG8_WAIT_L(0); PG8_BAR; PG8_MMA(0, 0, At, B0); PG8_MMA(0, 1, At, B1); PG8_BAR; PG8_SCHED;
            PG8_LDA(At, 1, 1); PG8_STAGE(PG8_SB(1, 0), b3, voffB); PG8_STAGE(PG8_SB(1, 1), b3 + hstep, voffB); PG8_STAGE(PG8_SA(1, 0), a3, voffA);
            PG8_WAIT_V(8); PG8_WAIT_L(0); PG8_BAR; PG8_MMA(1, 0, At, B0); PG8_MMA(1, 1, At, B1); PG8_BAR; PG8_SCHED;
            } else {
            PG8_LDB(B0, 0, 0); PG8_SCHED; PG8_LDA(At, 0, 0); PG8_STAGE(PG8_SA(1, 1), a1 + hstep, voffA);
            PG8_WAIT_L(8); PG8_BAR; PG8_WAIT_L(0); PG8_MMA(0, 0, At, B0); PG8_BAR; PG8_SCHED;
            PG8_LDB(B1, 0, 1); PG8_STAGE(PG8_SB(0, 0), b2, voffB);
            PG8_BAR; PG8_WAIT_L(0); PG8_MMA(0, 1, At, B1); PG8_BAR;
            PG8_LDA(At, 0, 1); PG8_STAGE(PG8_SA(0, 0), a2, voffA);
            PG8_BAR; PG8_WAIT_L(0); PG8_MMA(1, 0, At, B0); PG8_BAR; PG8_SCHED;
            PG8_STAGE(PG8_SB(0, 1), b2 + hstep, voffB);
            PG8_WAIT_V(6); PG8_BAR; PG8_MMA(1, 1, At, B1); PG8_BAR;
            PG8_LDB(B0, 1, 0); PG8_SCHED; PG8_LDA(At, 1, 0); PG8_STAGE(PG8_SA(0, 1), a2 + hstep, voffA);
            PG8_WAIT_L(8); PG8_BAR; PG8_WAIT_L(0); PG8_MMA(0, 0, At, B0); PG8_BAR; PG8_SCHED;
            PG8_LDB(B1, 1, 1); PG8_STAGE(PG8_SB(1, 0), b3, voffB);
            PG8_BAR; PG8_WAIT_L(0); PG8_MMA(0, 1, At, B1); PG8_BAR;
            PG8_LDA(At, 1, 1); PG8_STAGE(PG8_SA(1, 0), a3, voffA);
            PG8_BAR; PG8_WAIT_L(0); PG8_MMA(1, 0, At, B0); PG8_BAR; PG8_SCHED;
            PG8_STAGE(PG8_SB(1, 1), b3 + hstep, voffB);
            PG8_WAIT_V(6); PG8_BAR; PG8_MMA(1, 1, At, B1); PG8_BAR;
            }
        }
        if constexpr (ALIGN_EPI) { if (wr == 0) PG8_BAR; }
        if constexpr (!Epi::AFTER_DRAIN) { E(acc, cur, wr, wc, fr, fq); S.done(cur); }
        if (!has_next) break;
#pragma unroll
        for (int a = 0; a < 2; ++a)
#pragma unroll
            for (int b = 0; b < 2; ++b)
#pragma unroll
                for (int m = 0; m < 4; ++m)
#pragma unroll
                    for (int n = 0; n < 2; ++n) acc[a][b][m][n] = (f32x4){0.f, 0.f, 0.f, 0.f};
        cur = nxt; cA = nA; cB = nB; ++ui;
        if constexpr (ALIGN_EPI) { if (wr == 1) PG8_BAR; }
    }
    PG8_WAIT_V(0);
    if constexpr (!ALIGN_EPI) { if (wr == 0) PG8_BAR; }
    PG8_BAR;
    if constexpr (Epi::AFTER_DRAIN) { E.fused(acc, cur, wr, wc, fr, fq, lds, wid, lane); S.done(cur); }
#undef PG8_SA
#undef PG8_SB
#undef PG8_STAGE
#undef PG8_LDA
#undef PG8_LDB
#undef PG8_MMA
#undef PG8_WAIT_V
#undef PG8_WAIT_L
#undef PG8_BAR
#undef PG8_SCHED
}
}
#define GAS __attribute__((address_space(1)))
#define LAS __attribute__((address_space(3)))
typedef unsigned short bf16;
typedef unsigned v4u __attribute__((ext_vector_type(4)));
typedef float f32x4 __attribute__((ext_vector_type(4)));
typedef short bf16x8 __attribute__((ext_vector_type(8)));
typedef GAS unsigned gu32;
typedef GAS unsigned long long gu64;
#define RLX_AGENT __ATOMIC_RELAXED, __HIP_MEMORY_SCOPE_AGENT
#define LDS_WAIT() asm volatile("s_waitcnt lgkmcnt(0)" ::: "memory")
#define VM_WAIT() asm volatile("s_waitcnt vmcnt(0)" ::: "memory")
__device__ __forceinline__ unsigned long long rt() { return __builtin_amdgcn_s_memrealtime(); }
__device__ __forceinline__ unsigned f2bf(float f) { unsigned u = __builtin_bit_cast(unsigned, f); return (u + 0x7fffu + ((u >> 16) & 1u)) >> 16; }
__device__ __forceinline__ unsigned pk2(float lo, float hi) { return f2bf(lo) | (f2bf(hi) << 16); }
#define XB_TMO      128
#define XB_XCNT(j)  (256  + 64 * (j))
#define XB_XSUB(j)  (1280 + 64 * (j))
#define XB_XGEN(j)  (2304 + 64 * (j))
#define XB_TOP      3328
#define XB_TOPGEN   3392
#define XCD_BAR_WORDS 3456
#define XB_SPIN_CAP (1u << 18)

__device__ __forceinline__ unsigned xb_ld(unsigned* p)              { return __hip_atomic_load(p, __ATOMIC_RELAXED, __HIP_MEMORY_SCOPE_AGENT); }
__device__ __forceinline__ unsigned xb_add(unsigned* p, unsigned v) { return __hip_atomic_fetch_add(p, v, __ATOMIC_RELAXED, __HIP_MEMORY_SCOPE_AGENT); }
__device__ __forceinline__ unsigned xb_xcc_id() { return (unsigned)__builtin_amdgcn_s_getreg((3 << 11) | 20) & 0xFu; }
#define XB_SPIN(cond, bar) do { unsigned _sp = 0; while (cond) { __builtin_amdgcn_s_sleep(1); \
    if ((++_sp & 255u) == 0u) { if (xb_ld(&(bar)[XB_TMO])) break; if (_sp > XB_SPIN_CAP) { atomicAdd(&(bar)[XB_TMO], 1u); break; } } } } while (0)

struct XcdBarrier {
    unsigned* bar; unsigned x;
    volatile LAS unsigned* st;
};

__device__ __forceinline__ XcdBarrier xcd_barrier_post(unsigned* bar, volatile LAS unsigned* st) {
    XcdBarrier b; b.bar = bar; b.x = xb_xcc_id(); b.st = st;
    if (threadIdx.x == 0) (void)xb_add(&bar[XB_XCNT(b.x)], 1u);
    return b;
}
__device__ __forceinline__ void xcd_barrier_complete(unsigned* bar, unsigned x, unsigned& nloc, unsigned& nx) {
    const unsigned G = gridDim.x * gridDim.y * gridDim.z;
    unsigned sum, cnt, mine, sp = 0u;
    for (;;) {
        sum = 0u; cnt = 0u; mine = 0u;
#pragma unroll
        for (unsigned j = 0; j < 16; ++j) { const unsigned c = xb_ld(&bar[XB_XCNT(j)]); sum += c; cnt += (c > 0u) ? 1u : 0u; mine = (j == x) ? c : mine; }
        if (sum == G) break;
        __builtin_amdgcn_s_sleep(1);
        if ((++sp & 255u) == 0u) { if (xb_ld(&bar[XB_TMO])) break; if (sp > XB_SPIN_CAP) { atomicAdd(&bar[XB_TMO], 1u); break; } }
    }
    nloc = mine > 0u ? mine : 1u; nx = cnt > 0u ? cnt : 1u;
}

__device__ __forceinline__ void xcd_barrier(const XcdBarrier& b) {
    asm volatile("s_waitcnt vmcnt(0)" ::: "memory");
    __syncthreads();
    if (threadIdx.x == 0) {
        unsigned* bar = b.bar;
        __builtin_amdgcn_s_waitcnt(0);
        unsigned nloc = b.st[0], nx = b.st[1];
        if (nloc == 0u) { xcd_barrier_complete(bar, b.x, nloc, nx); b.st[0] = nloc; b.st[1] = nx; }
        const unsigned old = xb_add(&bar[XB_XSUB(b.x)], 1u);
        const unsigned gen = old / nloc;
        if (old + 1u == (gen + 1u) * nloc) {
            __builtin_amdgcn_fence(__ATOMIC_RELEASE, "agent");
            asm volatile("s_waitcnt vmcnt(0)" ::: "memory");
            const unsigned og = xb_add(&bar[XB_TOP], 1u);
            const unsigned tg = og / nx;
            if (og + 1u == (tg + 1u) * nx) xb_add(&bar[XB_TOPGEN], 1u);
            else XB_SPIN(xb_ld(&bar[XB_TOPGEN]) == tg, bar);
            __builtin_amdgcn_fence(__ATOMIC_ACQUIRE, "agent");
            xb_add(&bar[XB_XGEN(b.x)], 1u);
            asm volatile("s_waitcnt vmcnt(0)" ::: "memory");
        } else {
            XB_SPIN(xb_ld(&bar[XB_XGEN(b.x)]) == gen, bar);
            __builtin_amdgcn_fence(__ATOMIC_ACQUIRE, "agent");
            asm volatile("s_waitcnt vmcnt(0)" ::: "memory");
        }
    }
    __syncthreads();
}

__device__ __forceinline__ float wave_sum(float v) {
#pragma unroll
    for (int o = 1; o < 64; o <<= 1) v += __shfl_xor(v, o);
    return v;
}
constexpr int NWAVES = 8;
constexpr int BATCH = 2, SEQ = 16384, DM = 1024, CTXL = 256, DEPTH = 4;
constexpr int TL = BATCH * SEQ;
constexpr int TC = BATCH * CTXL;
constexpr int TA = TL + TC;
constexpr int EVEN_IN = 3072, ODD_IN = 1536, PQ_N = 2048, NEXP = 16384;
constexpr float EPS = 1e-6f;
constexpr float LOG2E = 1.4426950408889634f;
constexpr float C2 = 0.125f * LOG2E;

constexpr size_t MiB = 1u << 20;
constexpr size_t WS_CTL = 0, CTL_ZERO_BYTES = 1 * MiB;
constexpr size_t WS_MOD = 1 * MiB;
constexpr size_t WS_ROPE = WS_MOD + 512 * 1024;
constexpr size_t WS_LAM = WS_ROPE + 64 * 1024;
constexpr size_t WS_WIE = 2 * MiB;
constexpr size_t WS_WOE = 14 * MiB;
constexpr size_t WS_WIO = 18 * MiB;
constexpr size_t WS_WOO = 24 * MiB;
constexpr size_t WS_WQ = 28 * MiB;
constexpr size_t WS_KEYS = 44 * MiB;
constexpr size_t WS_U = 48 * MiB;
constexpr size_t WS_V = 176 * MiB;
constexpr size_t WS_X = 304 * MiB;
constexpr size_t WS_H = 434 * MiB;
constexpr size_t WS_P = 499 * MiB;
constexpr size_t WS_O = 694 * MiB;
constexpr size_t WS_IDX = 759 * MiB;
constexpr size_t WS_GATE = 776 * MiB;
constexpr size_t WS_END = 793 * MiB;
constexpr int CW_BAR = 4096;

constexpr int RING_OFF = 0, RING_BYTES = 131072;
constexpr int LDSCTL_OFF = RING_BYTES, MISC_OFF = LDSCTL_OFF + 320;
constexpr int LDS_BYTES = 147456;

namespace att {
typedef short bf16x8 __attribute__((ext_vector_type(8)));
typedef short s16x4 __attribute__((ext_vector_type(4)));
typedef float f32x16 __attribute__((ext_vector_type(16)));
typedef unsigned u32x4 __attribute__((ext_vector_type(4)));
typedef LAS unsigned char* lptr;
constexpr int KROWB = 144, KIMG = 64 * KROWB;
constexpr int ST_BYTES = 2 * KIMG + 64 * 128 * 2;
constexpr int L_WSF = 2 * ST_BYTES, L_RPB = L_WSF + NWAVES * 256, L_END = L_RPB + 2048;
static_assert(L_END <= RING_BYTES, "attention LDS");
constexpr float THR = 4.f;
constexpr int PLD = EVEN_IN;

__device__ __forceinline__ int crow(int r, int hi) { return (r & 3) + 8 * (r >> 2) + 4 * hi; }
__device__ __forceinline__ unsigned cvtpk(float lo, float hi) { typedef float f2 __attribute__((ext_vector_type(2))); typedef __bf16 b2 __attribute__((ext_vector_type(2)));
    f2 v = {lo, hi}; b2 b = __builtin_convertvector(v, b2); return __builtin_bit_cast(unsigned, b); }
__device__ __forceinline__ float partner32(float v, int hi) {
    auto rr = __builtin_amdgcn_permlane32_swap(__float_as_uint(v), __float_as_uint(v), false, false);
    return __uint_as_float(hi ? rr[0] : rr[1]);
}
typedef short v4i16_t __attribute__((ext_vector_type(4)));
__device__ __forceinline__ s16x4 vtr(lptr p) { return __builtin_bit_cast(s16x4, __builtin_amdgcn_ds_read_tr16_b64_v4i16((LAS v4i16_t*)p)); }

template <int NKI, int DV> struct Stager {
    u32x4 kreg[NKI], vreg[DV / 64];
    __device__ __forceinline__ void load(const bf16* P, int ldp, size_t rowbase, int kcol, int vcol, int tid) {
#pragma unroll
        for (int i = 0; i < NKI; ++i) { const int c = tid + 512 * i, row = c / (8 * NKI), ch = c % (8 * NKI);
            kreg[i] = *(const u32x4*)(P + (rowbase + row) * (size_t)ldp + kcol + ch * 8); }
#pragma unroll
        for (int i = 0; i < DV / 64; ++i) { const int c = tid + 512 * i, row = c / (DV / 8), ch = c % (DV / 8);
            vreg[i] = *(const u32x4*)(P + (rowbase + row) * (size_t)ldp + vcol + ch * 8); }
    }
    __device__ __forceinline__ void store(lptr st, int tid) const {
#pragma unroll
        for (int i = 0; i < NKI; ++i) { const int c = tid + 512 * i, row = c / (8 * NKI), ch = c % (8 * NKI);
            *(LAS u32x4*)(st + (ch >> 3) * KIMG + row * KROWB + (ch & 7) * 16) = kreg[i]; }
#pragma unroll
        for (int i = 0; i < DV / 64; ++i) { const int c = tid + 512 * i, row = c / (DV / 8), ch = c % (DV / 8);
            *(LAS u32x4*)(st + NKI * KIMG + (ch >> 2) * 4096 + (row >> 3) * 512 + (row & 7) * 64 + (ch & 3) * 16) = vreg[i]; }
    }
};

__device__ __forceinline__ void qk_tile(f32x16& p0, f32x16& p1, lptr kimg, const bf16x8 (&qr)[4], int r32, int hi) {
    p0 = f32x16{}; p1 = f32x16{};
    lptr kb = kimg + r32 * KROWB + hi * 16;
#pragma unroll
    for (int d0 = 0; d0 < 4; ++d0) {
        const bf16x8 a0 = *(LAS bf16x8*)(kb + d0 * 32), a1 = *(LAS bf16x8*)(kb + 32 * KROWB + d0 * 32);
        p0 = __builtin_amdgcn_mfma_f32_32x32x16_bf16(a0, qr[d0], p0, 0, 0, 0);
        p1 = __builtin_amdgcn_mfma_f32_32x32x16_bf16(a1, qr[d0], p1, 0, 0, 0);
    }
}
template <int DV> struct WaveAcc { f32x16 o[DV / 32]; float m, l;
    __device__ __forceinline__ void init() {
#pragma unroll
        for (int c = 0; c < DV / 32; ++c) o[c] = f32x16{};
        m = -INFINITY; l = 0.f; } };

template <int DV> __device__ __forceinline__ void softmax_pv(WaveAcc<DV>& A, f32x16& p0, f32x16& p1, lptr vimg, LAS float* wsf, int lane, int r32, int hi) {
    float mx = fmaxf(p0[0], p1[0]);
#pragma unroll
    for (int r = 1; r < 16; ++r) mx = fmaxf(mx, fmaxf(p0[r], p1[r]));
    mx = fmaxf(mx, partner32(mx, hi));
    if (__any(mx > A.m + THR)) {
        const float mn = fmaxf(A.m, mx);
        const float alpha = (mn == -INFINITY) ? 1.f : __builtin_amdgcn_exp2f(A.m - mn);
        A.l *= alpha; A.m = mn;
        if (hi == 0) wsf[r32] = alpha;
        __builtin_amdgcn_s_waitcnt(0xc07f);
        asm volatile("" ::: "memory");
#pragma unroll
        for (int r = 0; r < 16; ++r) { const float a = wsf[crow(r, hi)];
#pragma unroll
            for (int c = 0; c < DV / 32; ++c) A.o[c][r] *= a; }
    }
    float s = 0.f;
#pragma unroll
    for (int r = 0; r < 16; ++r) { p0[r] = __builtin_amdgcn_exp2f(p0[r] - A.m); p1[r] = __builtin_amdgcn_exp2f(p1[r] - A.m); s += p0[r] + p1[r]; }
    A.l += s;
    u32x4 pw[4];
#pragma unroll
    for (int k = 0; k < 2; ++k) {
        pw[k] = (u32x4){cvtpk(p0[8 * k + 0], p0[8 * k + 1]), cvtpk(p0[8 * k + 2], p0[8 * k + 3]), cvtpk(p0[8 * k + 4], p0[8 * k + 5]), cvtpk(p0[8 * k + 6], p0[8 * k + 7])};
        pw[2 + k] = (u32x4){cvtpk(p1[8 * k + 0], p1[8 * k + 1]), cvtpk(p1[8 * k + 2], p1[8 * k + 3]), cvtpk(p1[8 * k + 4], p1[8 * k + 5]), cvtpk(p1[8 * k + 6], p1[8 * k + 7])};
    }
    lptr vp = vimg + (4 * hi + ((lane & 15) >> 2)) * 64 + ((lane >> 4) & 1) * 32 + (lane & 3) * 8;
#pragma unroll
    for (int ks = 0; ks < 4; ++ks)
#pragma unroll
        for (int c = 0; c < DV / 32; ++c) {
            const s16x4 lo = vtr(vp + c * 4096 + ks * 1024), h2 = vtr(vp + c * 4096 + ks * 1024 + 512);
            const bf16x8 vf = (bf16x8){lo[0], lo[1], lo[2], lo[3], h2[0], h2[1], h2[2], h2[3]};
            A.o[c] = __builtin_amdgcn_mfma_f32_32x32x16_bf16(__builtin_bit_cast(bf16x8, pw[ks]), vf, A.o[c], 0, 0, 0);
        }
}
__device__ __forceinline__ void inv_rows(float (&invr)[16], float l, float extra, LAS float* wsf, int r32, int hi) {
    const float lt = l + partner32(l, hi) + extra;
    if (hi == 0) wsf[32 + r32] = 1.f / lt;
    __builtin_amdgcn_s_waitcnt(0xc07f); asm volatile("" ::: "memory");
#pragma unroll
    for (int r = 0; r < 16; ++r) invr[r] = wsf[32 + crow(r, hi)];
}
__device__ __forceinline__ void load_q(bf16x8 (&qr)[4], const bf16* P, int ldp, size_t qrow0, int qcol, int r32, int hi) {
#pragma unroll
    for (int d0 = 0; d0 < 4; ++d0) qr[d0] = *(const bf16x8*)(P + (qrow0 + r32) * (size_t)ldp + qcol + d0 * 16 + hi * 8);
}
__device__ __forceinline__ void store_o64(const WaveAcc<64>& A, const float (&invr)[16], bf16* O, size_t qrow0, int ocol, int r32, int hi) {
#pragma unroll
    for (int r = 0; r < 16; ++r)
#pragma unroll
        for (int c = 0; c < 2; ++c) O[(qrow0 + crow(r, hi)) * (size_t)DM + ocol + 32 * c + r32] = (bf16)f2bf(A.o[c][r] * invr[r]);
}

__device__ __forceinline__ void na_unit(bool isctx, int b, int h, int g4, const bf16* P, bf16* O, const float* rpb, LAS unsigned char* lds) {
    int tid = threadIdx.x; asm volatile("" : "+v"(tid));
    const int lane = tid & 63, r32 = lane & 31, hi = lane >> 5, w = __builtin_amdgcn_readfirstlane(tid >> 6);
    LAS float* rpbl = (LAS float*)(lds + L_RPB); LAS float* wsf = (LAS float*)(lds + L_WSF) + w * 64;
    for (int i = tid; i < 15 * 31; i += 512) rpbl[i] = rpb[h * 465 + i] * LOG2E;
    const size_t ctx0 = (size_t)TL + (size_t)b * CTXL;
    const int qgr = 4 * g4 + (w >> 1), qcb = 32 * (w & 1);
    const size_t qrow0 = isctx ? ctx0 + 32 * w : (size_t)b * SEQ + qgr * 64 + qcb;
    bf16x8 qr[4]; load_q(qr, P, EVEN_IN, qrow0, h * 64, r32, hi);
    const int kr_lo = max(4 * g4 - 4, 0), kr_hi = min(max(4 * g4 - 1, 0), 248) + 8;
    const int nt = isctx ? 4 : 4 + (kr_hi - kr_lo);
    const int rs = min(max(qgr - 4, 0), 248);
    const int kcol = 512 + h * 64, vcol = 1024 + h * 64;
    WaveAcc<64> A; A.init();
    Stager<1, 64> sg;
#define NA_ROWBASE(t) ((t) < 4 ? ctx0 + 64 * (t) : (size_t)b * SEQ + (size_t)(kr_lo + (t) - 4) * 64)
    sg.load(P, EVEN_IN, NA_ROWBASE(0), kcol, vcol, tid); sg.store(lds, tid);
    if (nt > 1) sg.load(P, EVEN_IN, NA_ROWBASE(1), kcol, vcol, tid);
    for (int t = 0; t < nt; ++t) {
        __syncthreads();
        if (t + 1 < nt) { sg.store(lds + ((t + 1) & 1) * ST_BYTES, tid); if (t + 2 < nt) sg.load(P, EVEN_IN, NA_ROWBASE(t + 2), kcol, vcol, tid); }
        lptr st = lds + (t & 1) * ST_BYTES;
        const int kr = kr_lo + t - 4;
        if (t < 4 || (kr >= rs && kr < rs + 8)) {
            f32x16 p0, p1; qk_tile(p0, p1, st, qr, r32, hi);
            if (t >= 4) {
                const int qc = qcb + r32; int cs4 = min(max(qc - 8, 0), 48) - 4 * hi;
                asm volatile("" : "+v"(cs4));
                LAS const float* bl = rpbl + (kr - qgr + 7) * 31 + (15 - qc + 4 * hi);
#pragma unroll
                for (int r = 0; r < 16; ++r) {
                    const int kk = (r & 3) + 8 * (r >> 2);
                    p0[r] = ((unsigned)(kk - cs4) < 16u) ? p0[r] + bl[kk] : -INFINITY;
                    p1[r] = ((unsigned)(kk + 32 - cs4) < 16u) ? p1[r] + bl[kk + 32] : -INFINITY;
                }
            }
            softmax_pv<64>(A, p0, p1, st + KIMG, wsf, lane, r32, hi);
        }
    }
#undef NA_ROWBASE
    float invr[16]; inv_rows(invr, A.l, 0.f, wsf, r32, hi);
    store_o64(A, invr, O, qrow0, h * 64, r32, hi);
    __syncthreads();
}

__device__ __forceinline__ void swa_unit(bool isctx, int b, int n, int qb, const bf16* P, bf16* O, const float* sink, LAS unsigned char* lds) {
    int tid = threadIdx.x; asm volatile("" : "+v"(tid));
    const int lane = tid & 63, r32 = lane & 31, hi = lane >> 5, w = __builtin_amdgcn_readfirstlane(tid >> 6);
    LAS float* wsf = (LAS float*)(lds + L_WSF) + w * 64;
    const size_t ctx0 = (size_t)TL + (size_t)b * CTXL;
    const int hq = 4 * n + (w >> 1), j = w & 1, q0 = 64 * qb;
    const size_t qrow0 = isctx ? ctx0 + q0 + 32 * j : (size_t)b * SEQ + q0 + 32 * j;
    bf16x8 qr[4]; load_q(qr, P, ODD_IN, qrow0, hq * 64, r32, hi);
    const int jlo = q0 >= 128 ? 0 : (128 - q0) / 64, jhi = min(5, (SEQ - q0 + 128) / 64);
    const int nt = isctx ? 4 : 4 + (jhi - jlo);
    const int kcol = 1024 + n * 64, vcol = 1280 + n * 64;
    WaveAcc<64> A; A.init();
    Stager<1, 64> sg;
#define SWA_KPOS0(t) (q0 - 128 + 64 * (jlo + (t) - 4))
#define SWA_ROWBASE(t) ((t) < 4 ? ctx0 + 64 * (t) : (size_t)b * SEQ + (size_t)SWA_KPOS0(t))
    sg.load(P, ODD_IN, SWA_ROWBASE(0), kcol, vcol, tid); sg.store(lds, tid);
    if (nt > 1) sg.load(P, ODD_IN, SWA_ROWBASE(1), kcol, vcol, tid);
    for (int t = 0; t < nt; ++t) {
        __syncthreads();
        if (t + 1 < nt) { sg.store(lds + ((t + 1) & 1) * ST_BYTES, tid); if (t + 2 < nt) sg.load(P, ODD_IN, SWA_ROWBASE(t + 2), kcol, vcol, tid); }
        lptr st = lds + (t & 1) * ST_BYTES;
        f32x16 p0, p1; qk_tile(p0, p1, st, qr, r32, hi);
        if (t >= 4) {
            const int dbase = SWA_KPOS0(t) - (q0 + 32 * j + r32) + 128;
#pragma unroll
            for (int r = 0; r < 16; ++r) {
                const int k0 = crow(r, hi);
                p0[r] = ((unsigned)(dbase + k0) <= 256u) ? p0[r] : -INFINITY;
                p1[r] = ((unsigned)(dbase + k0 + 32) <= 256u) ? p1[r] : -INFINITY;
            }
        }
        softmax_pv<64>(A, p0, p1, st + KIMG, wsf, lane, r32, hi);
    }
#undef SWA_ROWBASE
#undef SWA_KPOS0
    float invr[16]; inv_rows(invr, A.l, __builtin_amdgcn_exp2f(sink[hq] * LOG2E - A.m), wsf, r32, hi);
    store_o64(A, invr, O, qrow0, hq * 64, r32, hi);
    __syncthreads();
}

__device__ __forceinline__ void diff_unit(bool isctx, int b, int h, int qb, const bf16* P, bf16* O, float lam, float osc, const float* subg, LAS unsigned char* lds) {
    int tid = threadIdx.x; asm volatile("" : "+v"(tid));
    const int lane = tid & 63, r32 = lane & 31, hi = lane >> 5, w = __builtin_amdgcn_readfirstlane(tid >> 6);
    LAS float* wsf = (LAS float*)(lds + L_WSF) + w * 64;
    const size_t ctx0 = (size_t)TL + (size_t)b * CTXL;
    const int mp = w >> 2, qg = w & 3;
    const size_t qrow0 = (isctx ? ctx0 : (size_t)b * SEQ) + 128 * qb + 32 * qg;
    bf16x8 qr[4]; load_q(qr, P, EVEN_IN, qrow0, 1536 + h * 128 + mp * 64, r32, hi);
    const int nt = isctx ? 4 : 4 + SEQ / 64;
    const int kcol = 2048 + h * 128, vcol = 2560 + h * 128;
    WaveAcc<128> A; A.init();
    Stager<2, 128> sg;
#define DF_ROWBASE(t) ((t) < 4 ? ctx0 + 64 * (t) : (size_t)b * SEQ + (size_t)((t) - 4) * 64)
    sg.load(P, EVEN_IN, DF_ROWBASE(0), kcol, vcol, tid); sg.store(lds, tid);
    if (nt > 1) sg.load(P, EVEN_IN, DF_ROWBASE(1), kcol, vcol, tid);
    for (int t = 0; t < nt; ++t) {
        __syncthreads();
        if (t + 1 < nt) { sg.store(lds + ((t + 1) & 1) * ST_BYTES, tid); if (t + 2 < nt) sg.load(P, EVEN_IN, DF_ROWBASE(t + 2), kcol, vcol, tid); }
        lptr st = lds + (t & 1) * ST_BYTES;
        f32x16 p0, p1; qk_tile(p0, p1, st + mp * KIMG, qr, r32, hi);
        softmax_pv<128>(A, p0, p1, st + 2 * KIMG, wsf, lane, r32, hi);
    }
#undef DF_ROWBASE
    float invr[16]; inv_rows(invr, A.l, 0.f, wsf, r32, hi);
    __syncthreads();
    LAS float* xch = (LAS float*)lds + qg * 4096;
    if (mp == 1) {
#pragma unroll
        for (int r = 0; r < 16; ++r)
#pragma unroll
            for (int c = 0; c < 4; ++c) xch[crow(r, hi) * 128 + 32 * c + r32] = A.o[c][r] * invr[r];
    }
    __syncthreads();
    if (mp == 0) {
        float gsub[4];
#pragma unroll
        for (int c = 0; c < 4; ++c) gsub[c] = subg[32 * c + r32] * osc;
#pragma unroll
        for (int r = 0; r < 16; ++r) {
            float ss = 0.f;
#pragma unroll
            for (int c = 0; c < 4; ++c) { const float v = A.o[c][r] * invr[r] - lam * xch[crow(r, hi) * 128 + 32 * c + r32]; A.o[c][r] = v; ss += v * v; }
#pragma unroll
            for (int o = 1; o < 32; o <<= 1) ss += __shfl_xor(ss, o);
            const float rs = __builtin_amdgcn_rsqf(ss * (1.f / 128.f) + EPS);
#pragma unroll
            for (int c = 0; c < 4; ++c) O[(qrow0 + crow(r, hi)) * (size_t)DM + 512 + h * 128 + 32 * c + r32] = (bf16)f2bf(A.o[c][r] * rs * gsub[c]);
        }
    }
    __syncthreads();
}
}

namespace peer {
typedef short bf16x8 __attribute__((ext_vector_type(8)));
typedef float f32x16 __attribute__((ext_vector_type(16)));
typedef unsigned u32x4 __attribute__((ext_vector_type(4)));
constexpr int KEYROWB = 272, KEYIMG = 128 * KEYROWB;
constexpr int L_KEYS = 0, L_TAB = 2 * KEYIMG;
static_assert(L_TAB + NWAVES * 2048 <= RING_BYTES, "peer LDS");

__device__ __forceinline__ void cex(float& a, float& b) { const float mx = fmaxf(a, b), mn = fminf(a, b); a = mx; b = mn; }
template <int OFF> __device__ __forceinline__ void sort16(float (&v)[64]) {
#pragma unroll
    for (int k = 2; k <= 16; k <<= 1)
#pragma unroll
        for (int j = k >> 1; j > 0; j >>= 1)
#pragma unroll
            for (int i = 0; i < 16; ++i) { const int l = i ^ j; if (l > i) { if ((i & k) == 0) cex(v[OFF + i], v[OFF + l]); else cex(v[OFF + l], v[OFF + i]); } }
}
__device__ __forceinline__ void merge16(float (&t)[16]) {
#pragma unroll
    for (int j = 8; j > 0; j >>= 1)
#pragma unroll
        for (int i = 0; i < 16; ++i) { const int l = i ^ j; if (l > i) cex(t[i], t[l]); }
}
__device__ __forceinline__ void top16_of_64(float (&v)[64], float (&out)[16]) {
    sort16<0>(v); sort16<16>(v); sort16<32>(v); sort16<48>(v);
    float a[16], b[16];
#pragma unroll
    for (int i = 0; i < 16; ++i) { a[i] = fmaxf(v[i], v[31 - i]); b[i] = fmaxf(v[32 + i], v[63 - i]); }
    merge16(a); merge16(b);
#pragma unroll
    for (int i = 0; i < 16; ++i) out[i] = fmaxf(a[i], b[15 - i]);
    merge16(out);
}
struct CandTab { int pos[16][16]; int n;
    constexpr CandTab() : pos{}, n(0) { for (int x = 0; x < 16; ++x) for (int y = 0; y < 16; ++y) { pos[x][y] = n; if ((x + 1) * (y + 1) <= 16) ++n; } } };
constexpr CandTab CT{};
static_assert(CT.n == 50, "50 candidate pairs");
template <int A, int B> struct CandPos { static constexpr int value = CT.pos[A][B]; };

template <int A, int B> __device__ __forceinline__ void cand_fill(float (&c)[64], const float (&top)[2][16]) {
    if constexpr ((A + 1) * (B + 1) <= 16) {
        const float s = __uint_as_float(__float_as_uint(top[0][A]) & ~127u) + __uint_as_float(__float_as_uint(top[1][B]) & ~127u);
        c[CT.pos[A][B]] = __uint_as_float((__float_as_uint(s) & ~255u) | (unsigned)(A * 16 + B));
    }
    if constexpr (B < 15) cand_fill<A, B + 1>(c, top);
    else if constexpr (A < 15) cand_fill<A + 1, 0>(c, top);
}
__device__ __forceinline__ void topk_wave(const bf16* PQ, size_t tok0, int h, LAS unsigned char* keys, LAS unsigned* tab, int* IDX, float* GATE, int lane) {
    const int r32 = lane & 31, hi = lane >> 5;
    float top[2][16];
#pragma unroll
    for (int p = 0; p < 2; ++p) {
        bf16x8 qf[8];
#pragma unroll
        for (int ks = 0; ks < 8; ++ks) qf[ks] = *(const bf16x8*)(PQ + (tok0 + r32) * (size_t)PQ_N + h * 256 + p * 128 + ks * 16 + hi * 8);
        float v[64];
#pragma unroll
        for (int nb = 0; nb < 4; ++nb) {
            f32x16 acc = f32x16{};
            LAS unsigned char* kb = keys + p * KEYIMG + (32 * nb + r32) * KEYROWB + hi * 16;
#pragma unroll
            for (int ks = 0; ks < 8; ++ks) acc = __builtin_amdgcn_mfma_f32_32x32x16_bf16(*(LAS bf16x8*)(kb + ks * 32), qf[ks], acc, 0, 0, 0);
#pragma unroll
            for (int r = 0; r < 16; ++r) { const unsigned n = 32 * nb + (r & 3) + 8 * (r >> 2) + 4 * hi; v[16 * nb + r] = __uint_as_float((__float_as_uint(acc[r]) & ~127u) | n); }
        }
        float mine[16]; top16_of_64(v, mine);
#pragma unroll
        for (int i = 0; i < 16; ++i) { const float o = att::partner32(mine[15 - i], hi); top[p][i] = fmaxf(mine[i], o); }
        merge16(top[p]);
    }
#pragma unroll
    for (int p = 0; p < 2; ++p)
#pragma unroll
        for (int j = 0; j < 4; ++j) {
            unsigned wv = 0;
#pragma unroll
            for (int e = 0; e < 4; ++e) wv |= (__float_as_uint(top[p][4 * j + e]) & 127u) << (8 * e);
            tab[(4 * p + j) * 64 + lane] = wv;
        }
    float c[64];
#pragma unroll
    for (int i = 0; i < 64; ++i) c[i] = -INFINITY;
    cand_fill<0, 0>(c, top);
    float res[16]; top16_of_64(c, res);
    float fv[16]; int eid[16];
    float mx = -INFINITY;
#pragma unroll
    for (int k = 0; k < 16; ++k) {
        const unsigned bits = __float_as_uint(res[k]); const unsigned a = (bits >> 4) & 15u, b = bits & 15u;
        const unsigned w1 = tab[(a >> 2) * 64 + lane], w2 = tab[(4 + (b >> 2)) * 64 + lane];
        const unsigned i1 = (w1 >> (8 * (a & 3))) & 127u, i2 = (w2 >> (8 * (b & 3))) & 127u;
        eid[k] = (int)(i1 * 128u + i2); fv[k] = __uint_as_float(bits & ~255u); mx = fmaxf(mx, fv[k]);
    }
    float sum = 0.f;
#pragma unroll
    for (int k = 0; k < 16; ++k) { fv[k] = __builtin_amdgcn_exp2f((fv[k] - mx) * LOG2E); sum += fv[k]; }
    const float inv = 1.f / sum;
    int* ip = IDX + (tok0 + r32) * 128 + h * 16; float* gp = GATE + (tok0 + r32) * 128 + h * 16;
#pragma unroll
    for (int k = 0; k < 16; ++k) fv[k] *= inv;
    if (hi == 0) {
        *(int4*)(ip) = make_int4(eid[0], eid[1], eid[2], eid[3]); *(int4*)(ip + 4) = make_int4(eid[4], eid[5], eid[6], eid[7]);
        *(float4*)(gp) = make_float4(fv[0], fv[1], fv[2], fv[3]); *(float4*)(gp + 4) = make_float4(fv[4], fv[5], fv[6], fv[7]);
    } else {
        *(int4*)(ip + 8) = make_int4(eid[8], eid[9], eid[10], eid[11]); *(int4*)(ip + 12) = make_int4(eid[12], eid[13], eid[14], eid[15]);
        *(float4*)(gp + 8) = make_float4(fv[8], fv[9], fv[10], fv[11]); *(float4*)(gp + 12) = make_float4(fv[12], fv[13], fv[14], fv[15]);
    }
}

__device__ __forceinline__ float gelu_f(float v) {
    const float av = fabsf(v), t = __builtin_amdgcn_rcpf(av * 0.2316418882f + 1.0f);
    float q = t * 0.5307027145f + (-0.7265760135f); q = q * t + 0.7107068705f; q = q * t + (-0.142248368f); q = q * t + 0.127414796f; q = q * t;
    const float e = __builtin_amdgcn_exp2f((v * v) * (-0.72134752044f));
    const float m = v * (q * e);
    return v < 0.f ? m : v - m;
}
typedef __bf16 bf2_t __attribute__((ext_vector_type(2)));
__device__ __forceinline__ float dot2u(unsigned a, unsigned b, float acc) { return __builtin_amdgcn_fdot2_f32_bf16(__builtin_bit_cast(bf2_t, a), __builtin_bit_cast(bf2_t, b), acc, false); }
__device__ __forceinline__ float dot8(const u32x4& a, const u32x4& b, float acc) {
    const unsigned a0 = a.x, a1 = a.y, a2 = a.z, a3 = a.w, b0 = b.x, b1 = b.y, b2 = b.z, b3 = b.w;
    acc = dot2u(a0, b0, acc); acc = dot2u(a1, b1, acc); acc = dot2u(a2, b2, acc); acc = dot2u(a3, b3, acc);
    return acc;
}
__device__ __forceinline__ void fma8(float (&f)[8], const u32x4& v, float w) {
    f[0] += w * __uint_as_float(v.x << 16); f[1] += w * __uint_as_float(v.x & 0xffff0000u);
    f[2] += w * __uint_as_float(v.y << 16); f[3] += w * __uint_as_float(v.y & 0xffff0000u);
    f[4] += w * __uint_as_float(v.z << 16); f[5] += w * __uint_as_float(v.z & 0xffff0000u);
    f[6] += w * __uint_as_float(v.w << 16); f[7] += w * __uint_as_float(v.w & 0xffff0000u);
}
__device__ __forceinline__ void expert_token(const bf16* Hrow, const int* idx, const float* gate, const bf16* U, const bf16* V, float (&f0)[8], float (&f1)[8], int lane) {
    const u32x4 h0 = *(const u32x4*)(Hrow + 8 * lane), h1 = *(const u32x4*)(Hrow + 512 + 8 * lane);
    const int i0 = idx[lane], i1 = idx[64 + lane];
    const float g0 = gate[lane], g1 = gate[64 + lane];
#pragma unroll
    for (int i = 0; i < 8; ++i) { f0[i] = 0.f; f1[i] = 0.f; }
    for (int g = 0; g < 16; ++g) {
        const int ireg = g < 8 ? i0 : i1; const float greg = g < 8 ? g0 : g1;
        int e[8]; u32x4 u0[8], u1[8], v0[8], v1[8];
#pragma unroll
        for (int k = 0; k < 8; ++k) { e[k] = __builtin_amdgcn_readlane(ireg, (g * 8 + k) & 63);
            const bf16* up = U + (size_t)e[k] * DM + 8 * lane; u0[k] = *(const u32x4*)up; u1[k] = *(const u32x4*)(up + 512); }
#pragma unroll
        for (int k = 0; k < 8; ++k) { const bf16* vp = V + (size_t)e[k] * DM + 8 * lane; v0[k] = *(const u32x4*)vp; v1[k] = *(const u32x4*)(vp + 512); }
        float d[8];
#pragma unroll
        for (int k = 0; k < 8; ++k) d[k] = dot8(h1, u1[k], dot8(h0, u0[k], 0.f));
        float d4[4];
#pragma unroll
        for (int k = 0; k < 4; ++k) { const bool up = (lane & 32) != 0; const float keep = up ? d[4 + k] : d[k], send = up ? d[k] : d[4 + k]; d4[k] = keep + __shfl_xor(send, 32); }
        float d2[2];
#pragma unroll
        for (int k = 0; k < 2; ++k) { const bool up = (lane & 16) != 0; const float keep = up ? d4[2 + k] : d4[k], send = up ? d4[k] : d4[2 + k]; d2[k] = keep + __shfl_xor(send, 16); }
        float d1; { const bool up = (lane & 8) != 0; const float keep = up ? d2[1] : d2[0], send = up ? d2[0] : d2[1]; d1 = keep + __shfl_xor(send, 8); }
        d1 += __shfl_xor(d1, 4); d1 += __shfl_xor(d1, 2); d1 += __shfl_xor(d1, 1);
        const float gk = __shfl(greg, (g * 8 + ((lane >> 3) & 7)) & 63);
        const float wv = gk * gelu_f(d1);
#pragma unroll
        for (int k = 0; k < 8; ++k) { const float wk = __uint_as_float(__builtin_amdgcn_readlane(__float_as_uint(wv), 8 * k)); fma8(f0, v0[k], wk); fma8(f1, v1[k], wk); }
    }
}
}

namespace peer_ref {
__device__ __forceinline__ float bf2f(bf16 b) { return __uint_as_float((unsigned)b << 16); }
__device__ __forceinline__ void topk_ref(const bf16* PQ, const bf16* keysL, int MR, int* IDX, float* GATE, LAS unsigned char* lds, int vcu, int G) {
    int tid = threadIdx.x; asm volatile("" : "+v"(tid));
    if (tid >= 128) return;
    LAS float* sc = (LAS float*)lds; LAS float* tv = sc + 128 * 128; LAS int* ti = (LAS int*)(tv + 2 * 16 * 128); LAS float* fvv = (LAS float*)(ti + 2 * 16 * 128);
    for (int item = vcu * 128 + tid; item < MR * 8; item += G * 128) {
        const int t = item >> 3, h = item & 7;
        for (int p = 0; p < 2; ++p) {
            const bf16* qp = PQ + (size_t)t * PQ_N + h * 256 + p * 128;
            for (int n = 0; n < 128; ++n) { const bf16* kp = keysL + (size_t)((h * 2 + p) * 128 + n) * 128; float s = 0.f;
                for (int d = 0; d < 128; ++d) s += bf2f(qp[d]) * bf2f(kp[d]);
                sc[n * 128 + tid] = s; }
            float pv = INFINITY; int pi = -1;
            for (int k = 0; k < 16; ++k) { float bv = -INFINITY; int bi = 0;
                for (int n = 0; n < 128; ++n) { const float s = sc[n * 128 + tid]; const bool ok = (s < pv) || (s == pv && n > pi); if (ok && s > bv) { bv = s; bi = n; } }
                tv[(p * 16 + k) * 128 + tid] = bv; ti[(p * 16 + k) * 128 + tid] = bi; pv = bv; pi = bi; }
        }
        float pv = INFINITY; int pi = -1; float mx = 0.f;
        for (int k = 0; k < 16; ++k) { float bv = -INFINITY; int bi = 0;
            for (int ab = 0; ab < 256; ++ab) { const float s = tv[(ab >> 4) * 128 + tid] + tv[(16 + (ab & 15)) * 128 + tid]; const bool ok = (s < pv) || (s == pv && ab > pi); if (ok && s > bv) { bv = s; bi = ab; } }
            if (k == 0) mx = bv;
            fvv[k * 128 + tid] = bv; pv = bv; pi = bi;
            IDX[(size_t)t * 128 + h * 16 + k] = ti[(bi >> 4) * 128 + tid] * 128 + ti[(16 + (bi & 15)) * 128 + tid]; }
        float sum = 0.f;
        for (int k = 0; k < 16; ++k) sum += expf(fvv[k * 128 + tid] - mx);
        for (int k = 0; k < 16; ++k) GATE[(size_t)t * 128 + h * 16 + k] = expf(fvv[k * 128 + tid] - mx) / sum;
    }
}
__device__ __forceinline__ void expert_ref(const bf16* Hrow, const int* idx, const float* gate, const bf16* U, const bf16* V, float (&f0)[8], float (&f1)[8], int lane) {
#pragma unroll
    for (int i = 0; i < 8; ++i) { f0[i] = 0.f; f1[i] = 0.f; }
    for (int j = 0; j < 128; ++j) {
        const int e = idx[j]; const float gt = gate[j];
        const bf16* up = U + (size_t)e * DM; const bf16* vp = V + (size_t)e * DM;
        float d = 0.f;
#pragma unroll
        for (int i = 0; i < 8; ++i) d += bf2f(Hrow[8 * lane + i]) * bf2f(up[8 * lane + i]) + bf2f(Hrow[512 + 8 * lane + i]) * bf2f(up[512 + 8 * lane + i]);
        d = wave_sum(d);
        const float a = 0.5f * d * (1.f + erff(d * 0.70710678118f));
        const float w = gt * a;
#pragma unroll
        for (int i = 0; i < 8; ++i) { f0[i] += w * bf2f(vp[8 * lane + i]); f1[i] += w * bf2f(vp[512 + 8 * lane + i]); }
    }
}
}

struct Frame {
    LAS unsigned char* lds;
    int tid, lane, wave, vcu, G;
};
__device__ __forceinline__ void p0_transpose_item(const float* W, int K, int N, bf16* WT, LAS float* scr, int item, int lane) {
    const int nblk = N / 32, kb = item / nblk, nb = item % nblk, k0 = 64 * kb, n0 = 32 * nb;
#pragma unroll 8
    for (int i = 0; i < 32; ++i) { const int kk = 2 * i + (lane >> 5); scr[kk * 33 + (lane & 31)] = W[(size_t)(k0 + kk) * N + n0 + (lane & 31)]; }
    LDS_WAIT(); asm volatile("" ::: "memory");
    const int c = lane & 7;
#pragma unroll
    for (int j = 0; j < 4; ++j) { const int n = (lane >> 3) + 8 * j; const LAS float* s = scr + (8 * c) * 33 + n;
        v4u o; o.x = pk2(s[0 * 33], s[1 * 33]); o.y = pk2(s[2 * 33], s[3 * 33]); o.z = pk2(s[4 * 33], s[5 * 33]); o.w = pk2(s[6 * 33], s[7 * 33]);
        *(GAS v4u*)(WT + (size_t)(n0 + n) * K + k0 + 8 * c) = o; }
    LDS_WAIT(); asm volatile("" ::: "memory");
}
__device__ __forceinline__ void cvt_copy(const float* src, bf16* dst, size_t n8, size_t gtid, size_t nthr) {
    for (size_t i = gtid; i < n8; i += nthr) {
        const f32x4 a = *(const f32x4*)(src + i * 8), b = *(const f32x4*)(src + i * 8 + 4);
        v4u o; o.x = pk2(a.x, a.y); o.y = pk2(a.z, a.w); o.z = pk2(b.x, b.y); o.w = pk2(b.z, b.w);
        *(v4u*)(dst + i * 8) = o;
    }
}
__device__ __forceinline__ float silu_f(float x) { return x / (1.f + __expf(-x)); }

struct Args { const float* in[21]; float* out; unsigned char* ws; int ph_lo, ph_hi; };
enum { IN_X = 0, IN_C, IN_CTX, IN_CCTX, IN_WMOD, IN_BMOD, IN_N1G, IN_N2G, IN_WIE, IN_WOE, IN_RPB, IN_DLAM, IN_SUBG, IN_WIO, IN_WOO, IN_SINK, IN_WQ, IN_KEYS, IN_U, IN_V, IN_FG };

template <int MODE> __device__ __forceinline__ void norm_row(const float* xrow, const float* g, const float* scale, const float* shift, bf16* ob, float* of, int lane) {
    const f32x4* xr = (const f32x4*)xrow + lane;
    f32x4 v[4]; float s = 0.f;
#pragma unroll
    for (int j = 0; j < 4; ++j) { v[j] = xr[64 * j]; s += (v[j].x * v[j].x + v[j].y * v[j].y) + (v[j].z * v[j].z + v[j].w * v[j].w); }
    const float rstd = __builtin_amdgcn_rsqf(wave_sum(s) * (1.f / DM) + EPS);
#pragma unroll
    for (int j = 0; j < 4; ++j) {
        const f32x4 gg = ((const f32x4*)g)[lane + 64 * j];
        f32x4 y = v[j] * rstd * gg;
        if (MODE == 0) {
            const f32x4 sc = ((const f32x4*)scale)[lane + 64 * j], sh = ((const f32x4*)shift)[lane + 64 * j];
            y = y * (sc + 1.f) + sh;
            ((unsigned long long*)ob)[lane + 64 * j] = (unsigned long long)pk2(y.x, y.y) | ((unsigned long long)pk2(y.z, y.w) << 32);
        } else ((f32x4*)of)[lane + 64 * j] = y;
    }
}
constexpr int NPHASES = 2 + 8 * DEPTH;
#ifndef MK_PER_PHASE
#define MK_PER_PHASE 0
#endif
#ifndef MK_KINDS
#define MK_KINDS 0x3FF
#endif
#define KIND_EN(c) (((MK_KINDS) >> (c)) & 1)
#ifndef MK_SKIP
#define MK_SKIP 0
#endif

__global__ void __launch_bounds__(NWAVES * 64, 2) fwd(Args args) {
    extern __shared__ __attribute__((aligned(16))) unsigned char lds_raw[];
    Frame F;
    F.lds = (LAS unsigned char*)lds_raw;
    F.tid = threadIdx.x; F.lane = F.tid & 63; F.wave = __builtin_amdgcn_readfirstlane(F.tid >> 6);
    F.G = gridDim.x; { const int bx = blockIdx.x; F.vcu = (F.G % 8 == 0) ? (bx % 8) * (F.G / 8) + bx / 8 : bx; }
    unsigned char* ws = args.ws;
    gu32* ctl = (gu32*)(ws + WS_CTL);
    for (int u = F.tid; u < (LDS_BYTES - LDSCTL_OFF) / 4; u += NWAVES * 64) ((LAS unsigned*)(F.lds + LDSCTL_OFF))[u] = 0u;
    __syncthreads();
    XcdBarrier bar = xcd_barrier_post((unsigned*)ctl + CW_BAR, (volatile LAS unsigned*)(F.lds + MISC_OFF) + 8);

#define WSL unsigned char* wsl = ws; asm volatile("" : "+s"(wsl)); int lane = threadIdx.x & 63; asm volatile("" : "+v"(lane)); (void)lane
#define MOD ((float*)(wsl + WS_MOD))
#define ROPE ((float*)(wsl + WS_ROPE))
#define LAM ((float*)(wsl + WS_LAM))
#define WIE ((bf16*)(wsl + WS_WIE))
#define WOE ((bf16*)(wsl + WS_WOE))
#define WIO ((bf16*)(wsl + WS_WIO))
#define WOO ((bf16*)(wsl + WS_WOO))
#define WQ ((bf16*)(wsl + WS_WQ))
#define KEYS ((bf16*)(wsl + WS_KEYS))
#define UB ((bf16*)(wsl + WS_U))
#define VB ((bf16*)(wsl + WS_V))
#define X ((float*)(wsl + WS_X))
#define H ((bf16*)(wsl + WS_H))
#define P ((bf16*)(wsl + WS_P))
#define O ((bf16*)(wsl + WS_O))
#define PQ ((bf16*)(wsl + WS_P))
#define IDX ((int*)(wsl + WS_IDX))
#define GATE ((float*)(wsl + WS_GATE))
    const int lo = args.ph_lo, hi = args.ph_hi;
    const int lane = F.lane, wave = F.wave, tid = F.tid, G = F.G, vcu = F.vcu;
    const int gw = vcu * NWAVES + wave, NGW = G * NWAVES;
#define IN(k) (lo <= (k) && (k) < hi)
#define SEAM(k) do { if (IN(k) && IN((k) + 1)) xcd_barrier(bar); } while (0)

    if (KIND_EN(8) && IN(0)) { WSL;
        LAS float* scr = (LAS float*)(F.lds + wave * 16384);
        constexpr int I_IE = 16 * 96, I_OE = 16 * 32, I_IO = 16 * 48, I_OO = 16 * 32, I_WQ = 16 * 64;
        constexpr int NIT = 2 * I_IE + 2 * I_OE + 2 * I_IO + 2 * I_OO + 4 * I_WQ;
        for (int it = gw; it < NIT; it += NGW) {
            int r = it;
            if (r < 2 * I_IE) { const int j = r / I_IE; p0_transpose_item(args.in[IN_WIE] + (size_t)j * 1024 * 3072, 1024, 3072, WIE + (size_t)j * 3072 * 1024, scr, r % I_IE, lane); continue; } r -= 2 * I_IE;
            if (r < 2 * I_OE) { const int j = r / I_OE; p0_transpose_item(args.in[IN_WOE] + (size_t)j * 1024 * 1024, 1024, 1024, WOE + (size_t)j * 1024 * 1024, scr, r % I_OE, lane); continue; } r -= 2 * I_OE;
            if (r < 2 * I_IO) { const int j = r / I_IO; p0_transpose_item(args.in[IN_WIO] + (size_t)j * 1024 * 1536, 1024, 1536, WIO + (size_t)j * 1536 * 1024, scr, r % I_IO, lane); continue; } r -= 2 * I_IO;
            if (r < 2 * I_OO) { const int j = r / I_OO; p0_transpose_item(args.in[IN_WOO] + (size_t)j * 1024 * 1024, 1024, 1024, WOO + (size_t)j * 1024 * 1024, scr, r % I_OO, lane); continue; } r -= 2 * I_OO;
            { const int j = r / I_WQ; p0_transpose_item(args.in[IN_WQ] + (size_t)j * 1024 * 2048, 1024, 2048, WQ + (size_t)j * 2048 * 1024, scr, r % I_WQ, lane); }
        }
        const size_t gtid = (size_t)vcu * 512 + tid, nthr = (size_t)G * 512;
        cvt_copy(args.in[IN_KEYS], KEYS, (size_t)DEPTH * 8 * 2 * 128 * 128 / 8, gtid, nthr);
        cvt_copy(args.in[IN_U], UB, (size_t)DEPTH * NEXP * DM / 8, gtid, nthr);
        cvt_copy(args.in[IN_V], VB, (size_t)DEPTH * NEXP * DM / 8, gtid, nthr);
        for (size_t i = gtid; i < 320 * 16; i += nthr) {
            const int pos = (int)(i >> 4), jf = (int)(i & 15); const int pp = pos < 256 ? pos : pos - 256;
            const float inv = powf(10000.f, -(float)jf / 16.f), ang = (float)pp * inv;
            ROPE[i * 2] = cosf(ang); ROPE[i * 2 + 1] = sinf(ang);
        }
        if (gtid < 2) {
            const float* lp = args.in[IN_DLAM] + gtid * 256; float s1 = 0.f, s2 = 0.f;
            for (int k = 0; k < 64; ++k) { s1 += lp[k] * lp[64 + k]; s2 += lp[128 + k] * lp[192 + k]; }
            LAM[gtid] = expf(s1) - expf(s2) + (0.8f - 0.6f * expf(-0.3f * (float)(2 * gtid)));
        }
        __syncthreads();
        LAS float* sv = (LAS float*)F.lds; LAS float* red = (LAS float*)(F.lds + 12288);
        for (int i = tid; i < 3072; i += 512) { const int r = i >> 10, k = i & 1023; sv[i] = silu_f(r < 2 ? args.in[IN_C][r * 1024 + k] : args.in[IN_CCTX][k]); }
        __syncthreads();
        for (int it = vcu; it < DEPTH * 96; it += G) {
            const int L = it / 96, n0 = (it % 96) * 64;
            const float* wm = args.in[IN_WMOD] + (size_t)L * 1024 * 6144 + n0 + lane;
            float a0 = 0.f, a1 = 0.f, a2 = 0.f;
#pragma unroll 8
            for (int k = wave * 128; k < wave * 128 + 128; ++k) { const float wv = wm[(size_t)k * 6144]; a0 += sv[k] * wv; a1 += sv[1024 + k] * wv; a2 += sv[2048 + k] * wv; }
            red[(wave * 3 + 0) * 64 + lane] = a0; red[(wave * 3 + 1) * 64 + lane] = a1; red[(wave * 3 + 2) * 64 + lane] = a2;
            __syncthreads();
            if (tid < 192) { const int r = tid >> 6, l = tid & 63; float s = 0.f;
#pragma unroll
                for (int w8 = 0; w8 < 8; ++w8) s += red[(w8 * 3 + r) * 64 + l];
                MOD[((size_t)L * 3 + r) * 6144 + n0 + l] = s + args.in[IN_BMOD][L * 6144 + n0 + l]; }
            __syncthreads();
        }
    }
    SEAM(0);

    for (int L = 0; L < DEPTH; ++L) {
        const int pb = 1 + 8 * L;
        const bool odd = (L & 1) != 0, last = (L == DEPTH - 1); const int j = L >> 1;
#define modL (MOD + (size_t)L * 3 * 6144)
#define xl ((L == 0) ? args.in[IN_X] : (const float*)X)
#define xc ((L == 0) ? args.in[IN_CTX] : (const float*)(X + (size_t)TL * DM))
        const int MR = last ? TL : TA;
        if (KIND_EN(0) && IN(pb)) { WSL;
            for (int row = gw; row < TA; row += NGW) {
                const bool lat = row < TL; const float* xr = lat ? xl + (size_t)row * DM : xc + (size_t)(row - TL) * DM;
                const float* mr = modL + (size_t)(lat ? (row >> 14) : 2) * 6144;
                norm_row<0>(xr, args.in[IN_N1G] + L * DM, mr + 1024, mr, H + (size_t)row * DM, nullptr, lane);
            }
        }
        SEAM(pb);
        if (KIND_EN(1) && IN(pb + 1)) { WSL;
            const int N = odd ? ODD_IN : EVEN_IN;
            if (MK_SKIP) { const size_t gtid = (size_t)vcu * 512 + threadIdx.x, nthr = (size_t)G * 512;
                for (size_t i = gtid; i < (size_t)TA * DM / 8; i += nthr) ((v4u*)O)[i] = (v4u){0u, 0u, 0u, 0u}; }
            pg8::Gemm g{H, odd ? WIO + (size_t)j * ODD_IN * DM : WIE + (size_t)j * EVEN_IN * DM, TA, N, DM}; pg8::StaticOrder S; S.init(TA, N, G, (int)blockIdx.x);
            pg8::EpiProj E{P, N, odd ? 1 : 0, ROPE, C2};
            pg8::gemm_phase<pg8::EpiProj, pg8::StaticOrder, true, true>(F.lds + RING_OFF, g, S, E);
        }
        SEAM(pb + 1);
        if (KIND_EN(2) && IN(pb + 2)) { WSL;
            if (!odd) {
                const float lam = LAM[j], osc = 1.f - (0.8f - 0.6f * expf(-0.3f * (float)L));
                const float* subg = args.in[IN_SUBG] + j * 128; const float* rpb = args.in[IN_RPB] + (size_t)j * 8 * 465;
                if (!(MK_SKIP & 1)) for (int u = vcu; u < 1024; u += G) { const int pair = (u & 255) >> 5, qb = (u & 31) + 32 * (u >> 8); att::diff_unit(false, pair >> 2, pair & 3, qb, P, O, lam, osc, subg, F.lds); }
                if (!(MK_SKIP & 2)) for (int u = vcu; u < 1024; u += G) { const int pair = (u & 255) >> 4, g4 = (u & 15) + 16 * (u >> 8); att::na_unit(false, pair >> 3, pair & 7, g4, P, O, rpb, F.lds); }
                if (!last) for (int u = vcu; u < 256; u += G) if ((u & 7) == 0) { const int k = u >> 3;
                    if (k < 16) { if (!(MK_SKIP & 1)) att::diff_unit(true, k >> 3, (k >> 1) & 3, k & 1, P, O, lam, osc, subg, F.lds); }
                    else { if (!(MK_SKIP & 2)) att::na_unit(true, (k - 16) >> 3, (k - 16) & 7, 0, P, O, rpb, F.lds); } }
            } else {
                const float* sink = args.in[IN_SINK] + j * 16;
                if (!(MK_SKIP & 4)) {
                for (int u = vcu; u < 2048; u += G) { const int pair = (u & 255) >> 5, qb = (u & 31) + 32 * (u >> 8); att::swa_unit(false, pair >> 2, pair & 3, qb, P, O, sink, F.lds); }
                if (!last) for (int u = vcu; u < 256; u += G) if ((u & 7) == 0) { const int k = u >> 3; att::swa_unit(true, k >> 4, (k >> 2) & 3, k & 3, P, O, sink, F.lds); }
                }
            }
        }
        SEAM(pb + 2);
        if (KIND_EN(3) && IN(pb + 3)) { WSL;
            pg8::Gemm g{O, odd ? WOO + (size_t)j * DM * DM : WOE + (size_t)j * DM * DM, MR, DM, DM}; pg8::StaticOrder S; S.init(MR, DM, G, (int)blockIdx.x);
            pg8::EpiResid E{xl, xc, X, modL + 2048};
            pg8::gemm_phase<pg8::EpiResid, pg8::StaticOrder, true, true>(F.lds + RING_OFF, g, S, E);
        }
        SEAM(pb + 3);
        if (KIND_EN(4) && IN(pb + 4)) { WSL;
            for (int row = gw; row < MR; row += NGW) {
                const float* mr = modL + (size_t)(row < TL ? (row >> 14) : 2) * 6144;
                norm_row<0>(X + (size_t)row * DM, args.in[IN_N2G] + L * DM, mr + 4096, mr + 3072, H + (size_t)row * DM, nullptr, lane);
            }
        }
        SEAM(pb + 4);
        if (KIND_EN(5) && IN(pb + 5)) { WSL;
            pg8::Gemm g{H, WQ + (size_t)L * PQ_N * DM, MR, PQ_N, DM}; pg8::StaticOrder S; S.init(MR, PQ_N, G, (int)blockIdx.x);
            pg8::EpiProj E{PQ, PQ_N, 2, ROPE, 1.f};
            pg8::gemm_phase<pg8::EpiProj, pg8::StaticOrder, true, true>(F.lds + RING_OFF, g, S, E);
        }
        SEAM(pb + 5);
        if (KIND_EN(6) && IN(pb + 6)) { WSL;
#if defined(PEER_REF_TOPK)
            peer_ref::topk_ref(PQ, KEYS + (size_t)L * 8 * 2 * 128 * 128, MR, IDX, GATE, F.lds, vcu, G);
#else
            const int nunits = 8 * (MR / 256); int cur_h = -1;
            int tid = threadIdx.x; asm volatile("" : "+v"(tid));
            for (int u = vcu; u < nunits; u += G) {
                int h, cb; if (u < 1024) { h = (u & 255) >> 5; cb = (u & 31) + 32 * (u >> 8); } else { h = (u - 1024) >> 1; cb = 128 + ((u - 1024) & 1); }
                if (h != cur_h) {
                    __syncthreads();
                    const bf16* kg = KEYS + (size_t)(L * 8 + h) * 2 * 128 * 128;
                    for (int c = tid; c < 4096; c += 512) { const int p = c >> 11, row = (c >> 4) & 127, ch = c & 15;
                        *(LAS v4u*)(F.lds + peer::L_KEYS + p * peer::KEYIMG + row * peer::KEYROWB + ch * 16) = *(const v4u*)(kg + (size_t)(p * 128 + row) * 128 + ch * 8); }
                    __syncthreads(); cur_h = h;
                }
                peer::topk_wave(PQ, (size_t)cb * 256 + wave * 32, h, F.lds + peer::L_KEYS, (LAS unsigned*)(F.lds + peer::L_TAB) + wave * 512, IDX, GATE, lane);
            }
#endif
        }
        SEAM(pb + 6);
        if (KIND_EN(7) && IN(pb + 7)) { WSL;
            const bf16* Ul = UB + (size_t)L * NEXP * DM; const bf16* Vl = VB + (size_t)L * NEXP * DM;
            for (int t = gw; t < MR; t += NGW) {
                float f0[8], f1[8];
#if defined(PEER_REF_EXP)
                peer_ref::expert_ref(H + (size_t)t * DM, IDX + (size_t)t * 128, GATE + (size_t)t * 128, Ul, Vl, f0, f1, lane);
#else
                peer::expert_token(H + (size_t)t * DM, IDX + (size_t)t * 128, GATE + (size_t)t * 128, Ul, Vl, f0, f1, lane);
#endif
                const float* g2 = modL + (size_t)(t < TL ? (t >> 14) : 2) * 6144 + 5120;
                float* xr = X + (size_t)t * DM;
#pragma unroll
                for (int c = 0; c < 2; ++c) {
                    const int d0 = c * 512 + 8 * lane; const float* ff = c ? f1 : f0;
                    f32x4 xa = *(const f32x4*)(xr + d0), xb = *(const f32x4*)(xr + d0 + 4);
                    const f32x4 ga = *(const f32x4*)(g2 + d0), gb = *(const f32x4*)(g2 + d0 + 4);
                    xa += ga * (f32x4){ff[0], ff[1], ff[2], ff[3]}; xb += gb * (f32x4){ff[4], ff[5], ff[6], ff[7]};
                    *(f32x4*)(xr + d0) = xa; *(f32x4*)(xr + d0 + 4) = xb;
                }
            }
        }
        SEAM(pb + 7);
    }
    if (KIND_EN(9) && IN(NPHASES - 1)) { WSL;
        for (int row = gw; row < TL; row += NGW) norm_row<1>(X + (size_t)row * DM, args.in[IN_FG], nullptr, nullptr, nullptr, args.out + (size_t)row * DM, lane);
    }
#undef IN
#undef SEAM
}

extern "C" void kernel_launch(void* const* d_in, const int* in_sizes, int n_in, void* d_out, int out_size, void* d_ws, size_t ws_size, hipStream_t stream) {
    static int grid = 0;
    if (grid == 0) {
        if (n_in != 21 || in_sizes[0] != TL * DM || out_size != TL * DM || ws_size < WS_END) {
            fprintf(stderr, "kernel_launch: unexpected shapes (n_in %d, in0 %d, out %d, ws %zu); nothing launched\n", n_in, n_in > 0 ? in_sizes[0] : -1, out_size, ws_size); grid = -1; return; }
        int dev = 0, cus = 0, per_cu = 0;
        if (hipGetDevice(&dev) != hipSuccess || hipDeviceGetAttribute(&cus, hipDeviceAttributeMultiprocessorCount, dev) != hipSuccess) { fprintf(stderr, "kernel_launch: device query failed\n"); grid = -1; return; }
        if (hipFuncSetAttribute((const void*)fwd, hipFuncAttributeMaxDynamicSharedMemorySize, LDS_BYTES) != hipSuccess) { fprintf(stderr, "kernel_launch: hipFuncSetAttribute failed\n"); grid = -1; return; }
        if (hipOccupancyMaxActiveBlocksPerMultiprocessor(&per_cu, (const void*)fwd, NWAVES * 64, LDS_BYTES) != hipSuccess || per_cu < 1)
            fprintf(stderr, "kernel_launch: note: occupancy query reports %d workgroups per CU\n", per_cu);
        (void)hipGetLastError();
        grid = cus;
    }
    if (grid < 0) return;
    if (hipMemsetAsync((char*)d_ws + WS_CTL, 0, CTL_ZERO_BYTES, stream) != hipSuccess) { fprintf(stderr, "kernel_launch: memset failed\n"); return; }
    Args a{};
    for (int i = 0; i < 21; ++i) a.in[i] = (const float*)d_in[i];
    a.out = (float*)d_out; a.ws = (unsigned char*)d_ws;
#if MK_PER_PHASE
    for (int p = 0; p < NPHASES; ++p) { a.ph_lo = p; a.ph_hi = p + 1; hipLaunchKernelGGL(fwd, dim3(grid), dim3(NWAVES * 64), LDS_BYTES, stream, a); }
#else
    a.ph_lo = 0; a.ph_hi = NPHASES;
    hipLaunchKernelGGL(fwd, dim3(grid), dim3(NWAVES * 64), LDS_BYTES, stream, a);
#endif
    const hipError_t le = hipPeekAtLastError();
    if (le != hipSuccess) fprintf(stderr, "kernel_launch: launch failed: %s\n", hipGetErrorName(le));
}
```

```cpp
#define MK_KINDS 0x3FF
#define MK_SKIP 0
#define MK_PER_PHASE 0
#define MK_REPEAT 0
#define MK_PROBE 0
#include <hip/hip_runtime.h>
#include <hip/hip_bf16.h>
#include <cstdio>
#include <cstdint>
#include <cstddef>
#include <cmath>
namespace pg8 {
#define PG8_LAS __attribute__((address_space(3)))
typedef unsigned short bf16_t;
typedef short bf16x8 __attribute__((ext_vector_type(8)));
typedef float f32x4 __attribute__((ext_vector_type(4)));
typedef unsigned u32x4 __attribute__((ext_vector_type(4)));
constexpr int BM = 256, BK = 64, HALF = 128, HTB = HALF * BK * 2  , STAGE_BYTES = 8 * HTB, NXCD = 8, WGM = 8;

__host__ __device__ __forceinline__ int lds_byte(int r, int c) { const int st = (r >> 4) * 2 + (c >> 5), rr = r & 15, cc = c & 31, ob = rr * 64 + cc * 2; return st * 1024 + (ob ^ (((ob >> 9) & 1) << 5)); }
__host__ __device__ __forceinline__ void stage_rc(int b, int& R, int& C) { const int st = b / 1024, sb = b % 1024, swz = sb ^ (((sb >> 9) & 1) << 5); R = (st >> 1) * 16 + swz / 64; C = (st & 1) * 32 + (swz % 64) / 2; }
__host__ __device__ __forceinline__ int perm32(int rho) { const int n = rho >> 4, i = rho & 15; return 8 * (i >> 2) + 4 * n + (i & 3); }

struct Unit { int pm, pn; };
struct Gemm { const bf16_t* A; const bf16_t* Bt; int M, N, K; };

struct StaticOrder {
    int nM, nN, nwg, G, c;
    __host__ __device__ void init(int M, int N, int G_, int c_) { nM = M / BM; nN = N / BM; nwg = nM * nN; G = G_; c = c_; }
    __host__ __device__ bool next(int i, Unit& u) const {
        const long L = (long)i * G + c; if (L >= nwg) return false;
        int wgid = (int)L; { const int q = nwg / NXCD, r = nwg % NXCD, xcd = wgid % NXCD, off = wgid / NXCD; wgid = (xcd < r ? xcd * (q + 1) : r * (q + 1) + (xcd - r) * q) + off; }
        const int nig = WGM * nN, gid = wgid / nig, fm = gid * WGM, gsz = (nM - fm) < WGM ? (nM - fm) : WGM;
        u.pm = fm + ((wgid % nig) % gsz); u.pn = (wgid % nig) / gsz; return true;
    }
    __device__ __forceinline__ void a_ready(const Unit&) const {}
    __device__ __forceinline__ void done(const Unit&) const {}
};

__device__ __forceinline__ unsigned cvt_pk_bf16(float lo, float hi) { unsigned r; asm volatile("v_cvt_pk_bf16_f32 %0, %1, %2" : "=v"(r) : "v"(lo), "v"(hi)); return r; }
typedef float f32x2 __attribute__((ext_vector_type(2)));
struct EpiProj {
    static constexpr bool PERM = true, AFTER_DRAIN = false;
    bf16_t* O; int ldc; int mode; const float* rope; float qscale;
    __device__ __forceinline__ void operator()(const f32x4 (&acc)[2][2][4][2], const Unit& u, int wr, int wc, int fr, int fq) const {
        const int pn = u.pn;
        bool isq = false, isrope = false;
        if (mode == 0) { isq = (pn < 2) || (pn == 6) || (pn == 7); isrope = (pn >= 6) && (pn <= 9); }
        else if (mode == 1) { isq = pn < 4; isrope = pn < 5; }
        isrope = isrope && (u.pm < 128);
        const float sc = isq ? qscale : 1.f;
        const int row0 = u.pm * BM + wr * 64 + fr, col0 = u.pn * BM + wc * 32 + 8 * fq;
        const float sgn = (fq & 2) ? 1.f : -1.f;
#pragma unroll
        for (int ai = 0; ai < 2; ++ai)
#pragma unroll
            for (int m = 0; m < 4; ++m) {
                const int row = row0 + ai * HALF + m * 16;
                bf16_t* rowp = O + (size_t)row * ldc + col0;
                f32x4 cs[4];
                if (isrope) {
                    const int t = row & 16383; const int pos = (wc & 1) ? 256 + (t & 63) : (t >> 6);
                    const f32x4* rp = (const f32x4*)(rope + (size_t)(pos * 16 + 8 * (fq & 1)) * 2);
                    cs[0] = rp[0]; cs[1] = rp[1]; cs[2] = rp[2]; cs[3] = rp[3];
                }
#pragma unroll
                for (int bj = 0; bj < 2; ++bj) {
                    f32x4 v0 = acc[ai][bj][m][0], v1 = acc[ai][bj][m][1];
                    if (isrope) {
                        float x[8] = {v0[0], v0[1], v0[2], v0[3], v1[0], v1[1], v1[2], v1[3]};
#pragma unroll
                        for (int j = 0; j < 8; ++j) {
                            const float pr = __shfl_xor(x[j], 32);
                            const float c = cs[j >> 1][(j & 1) * 2], s = cs[j >> 1][(j & 1) * 2 + 1];
                            x[j] = x[j] * c + sgn * pr * s;
                        }
                        v0 = (f32x4){x[0], x[1], x[2], x[3]}; v1 = (f32x4){x[4], x[5], x[6], x[7]};
                    }
                    v0 = v0 * sc; v1 = v1 * sc;
                    u32x4 w; w.x = cvt_pk_bf16(v0[0], v0[1]); w.y = cvt_pk_bf16(v0[2], v0[3]); w.z = cvt_pk_bf16(v1[0], v1[1]); w.w = cvt_pk_bf16(v1[2], v1[3]);
                    *(u32x4*)(rowp + bj * HALF) = w;
                }
            }
    }
};
struct EpiResid {
    static constexpr bool PERM = false, AFTER_DRAIN = false;
    const float* base_lat; const float* base_ctx; float* out; const float* gate;
    __device__ __forceinline__ void operator()(const f32x4 (&acc)[2][2][4][2], const Unit& u, int wr, int wc, int fr, int fq) const {
        const int row0 = u.pm * BM + wr * 64 + fr, col0 = u.pn * BM + wc * 32 + 4 * fq;
        const bool lat = u.pm < 128;
        const int mrow = lat ? (u.pm >> 6) : 2;
        const float* gp = gate + (size_t)mrow * 6144 + col0;
        f32x4 gv[2][2];
#pragma unroll
        for (int bj = 0; bj < 2; ++bj)
#pragma unroll
            for (int n = 0; n < 2; ++n) gv[bj][n] = *(const f32x4*)(gp + bj * HALF + n * 16);
#pragma unroll
        for (int ai = 0; ai < 2; ++ai)
#pragma unroll
            for (int m = 0; m < 4; ++m) {
                const int row = row0 + ai * HALF + m * 16;
                const float* bp = lat ? base_lat + (size_t)row * 1024 + col0 : base_ctx + (size_t)(row - 32768) * 1024 + col0;
                float* op = out + (size_t)row * 1024 + col0;
#pragma unroll
                for (int bj = 0; bj < 2; ++bj)
#pragma unroll
                    for (int n = 0; n < 2; ++n) { const f32x4 b = *(const f32x4*)(bp + bj * HALF + n * 16); *(f32x4*)(op + bj * HALF + n * 16) = b + gv[bj][n] * acc[ai][bj][m][n]; }
            }
    }
};
template <class Epi, class Sched, bool ALIGN_EPI = false, bool SP2 = false>
__device__ __forceinline__ void gemm_phase(PG8_LAS unsigned char* lds, const Gemm g, const Sched& S, const Epi& E) {
    int tid = threadIdx.x; asm volatile("" : "+v"(tid));
    const int wid = __builtin_amdgcn_readfirstlane(tid >> 6), lane = tid & 63, wr = wid >> 2, wc = wid & 3, fr = lane & 15, fq = lane >> 4;
    const int K = g.K, nt = K / BK;
    unsigned voffA[2], voffB[2];
#pragma unroll
    for (int i = 0; i < 2; ++i) { int R, C; stage_rc(tid * 16 + i * 8192, R, C); const int Rb = Epi::PERM ? ((R & ~31) + perm32(R & 31)) : R;
        voffA[i] = (unsigned)(R * K + C) * 2u; voffB[i] = (unsigned)(Rb * K + C) * 2u; }
    const size_t kstep = (size_t)(BK * 2);
    const size_t hstep = (size_t)HALF * K * 2;
    const size_t tstep = 2 * hstep;
    const unsigned ldsw = (unsigned)wid * 1024u;
    const int aoff = lds_byte(wr * 64 + fr, fq * 8), boff = lds_byte(wc * 32 + fr, fq * 8);
#define PG8_SA(b, h) (((b) * 2 + (h)) * HTB)
#define PG8_SB(b, h) ((4 + (b) * 2 + (h)) * HTB)
#define PG8_STAGE(bufoff, gbase, voff) do { _Pragma("unroll") for (int _i = 0; _i < 2; ++_i) \
        __builtin_amdgcn_global_load_lds((const unsigned*)((const char*)(gbase) + (voff)[_i]), (PG8_LAS unsigned*)(lds + (bufoff) + ldsw + _i * 8192), 16, 0, 0); } while (0)
#define PG8_LDA(dst, b, h) do { _Pragma("unroll") for (int m = 0; m < 4; ++m) _Pragma("unroll") for (int k = 0; k < 2; ++k) dst[m][k] = *(const PG8_LAS bf16x8*)(lds + PG8_SA(b, h) + aoff + m * 2048 + k * 1024); } while (0)
#define PG8_LDB(dst, b, h) do { _Pragma("unroll") for (int n = 0; n < 2; ++n) _Pragma("unroll") for (int k = 0; k < 2; ++k) dst[n][k] = *(const PG8_LAS bf16x8*)(lds + PG8_SB(b, h) + boff + n * 2048 + k * 1024); } while (0)
#define PG8_MMA(ai, bj, At, Bt) do { __builtin_amdgcn_s_setprio(1); _Pragma("unroll") for (int m = 0; m < 4; ++m) _Pragma("unroll") for (int n = 0; n < 2; ++n) _Pragma("unroll") for (int k = 0; k < 2; ++k) \
        acc[ai][bj][m][n] = __builtin_amdgcn_mfma_f32_16x16x32_bf16(Bt[n][k], At[m][k], acc[ai][bj][m][n], 0, 0, 0); __builtin_amdgcn_s_setprio(0); } while (0)
#define PG8_WAIT_V(n) asm volatile("s_waitcnt vmcnt(" #n ")" ::: "memory")
#define PG8_WAIT_L(n) asm volatile("s_waitcnt lgkmcnt(" #n ")" ::: "memory")
#define PG8_BAR __builtin_amdgcn_s_barrier()
#define PG8_SCHED __builtin_amdgcn_sched_barrier(0)
    Unit cur, nxt; int ui = 0;
    if (!S.next(0, cur)) return;
    f32x4 acc[2][2][4][2];
#pragma unroll
    for (int a = 0; a < 2; ++a)
#pragma unroll
        for (int b = 0; b < 2; ++b)
#pragma unroll
            for (int m = 0; m < 4; ++m)
#pragma unroll
                for (int n = 0; n < 2; ++n) acc[a][b][m][n] = (f32x4){0.f, 0.f, 0.f, 0.f};
    bf16x8 At[4][2], B0[2][2], B1[2][2];
    const char* cA = (const char*)g.A + (size_t)cur.pm * tstep; const char* cB = (const char*)g.Bt + (size_t)cur.pn * tstep;
    S.a_ready(cur);
    if constexpr (SP2) {
        PG8_STAGE(PG8_SB(0, 0), cB, voffB); PG8_STAGE(PG8_SB(0, 1), cB + hstep, voffB); PG8_STAGE(PG8_SA(0, 0), cA, voffA); PG8_STAGE(PG8_SA(0, 1), cA + hstep, voffA);
        if (wr == 1) PG8_BAR;
        PG8_WAIT_V(2); PG8_BAR;
        PG8_STAGE(PG8_SB(1, 0), cB + kstep, voffB); PG8_STAGE(PG8_SA(1, 0), cA + kstep, voffA); PG8_STAGE(PG8_SB(1, 1), cB + hstep + kstep, voffB);
        PG8_WAIT_V(6); PG8_BAR;
    } else {
        PG8_STAGE(PG8_SB(0, 0), cB, voffB); PG8_STAGE(PG8_SA(0, 0), cA, voffA); PG8_STAGE(PG8_SB(0, 1), cB + hstep, voffB); PG8_STAGE(PG8_SA(0, 1), cA + hstep, voffA);
        if (wr == 1) PG8_BAR;
        PG8_WAIT_V(4); PG8_BAR;
        PG8_STAGE(PG8_SB(1, 0), cB + kstep, voffB); PG8_STAGE(PG8_SA(1, 0), cA + kstep, voffA); PG8_STAGE(PG8_SB(1, 1), cB + hstep + kstep, voffB);
        PG8_WAIT_V(6); PG8_BAR;
    }
    for (;;) {
        const bool has_next = S.next(ui + 1, nxt);
        const char* nA = has_next ? (const char*)g.A + (size_t)nxt.pm * tstep : cA; const char* nB = has_next ? (const char*)g.Bt + (size_t)nxt.pn * tstep : cB;
        for (int t = 0; t < nt; t += 2) {
            const bool last = (t == nt - 2);
            const char* a1 = cA + (size_t)(t + 1) * kstep;
            const char* a2 = last ? nA : cA + (size_t)(t + 2) * kstep; const char* b2 = last ? nB : cB + (size_t)(t + 2) * kstep;
            const char* a3 = a2 + kstep; const char* b3 = b2 + kstep;
            if (last && has_next) S.a_ready(nxt);
            if constexpr (SP2) {
            PG8_LDB(B0, 0, 0); PG8_LDB(B1, 0, 1); PG8_SCHED; PG8_LDA(At, 0, 0); PG8_STAGE(PG8_SA(1, 1), a1 + hstep, voffA);
            PG8_WAIT_V(8); PG8_WAIT_L(0); PG8_BAR; PG8_MMA(0, 0, At, B0); PG8_MMA(0, 1, At, B1); PG8_BAR; PG8_SCHED;
            PG8_LDA(At, 0, 1); PG8_STAGE(PG8_SB(0, 0), b2, voffB); PG8_STAGE(PG8_SB(0, 1), b2 + hstep, voffB); PG8_STAGE(PG8_SA(0, 0), a2, voffA);
            PG8_WAIT_V(8); PG8_WAIT_L(0); PG8_BAR; PG8_MMA(1, 0, At, B0); PG8_MMA(1, 1, At, B1); PG8_BAR; PG8_SCHED;
            PG8_LDB(B0, 1, 0); PG8_LDB(B1, 1, 1); PG8_SCHED; PG8_LDA(At, 1, 0); PG8_STAGE(PG8_SA(0, 1), a2 + hstep, voffA);
            PG8_WAIT_V(8); PG8_WAIT_L(0); PG8_BAR; PG8_MMA(0, 0, At, B0); PG8_MMA(0, 1, At, B1); PG8_BAR; PG8_SCHED;
            PG8_LDA(At, 1, 1); PG8_STAGE(PG8_SB(1, 0), b3, voffB); PG8_STAGE(PG8_SB(1, 1), b3 + hstep, voffB); PG8_STAGE(PG8_SA(1, 0), a3, voffA);
            PG8_WAIT_V(8); PG8_WAIT_L(0); PG8_BAR; PG8_MMA(1, 0, At, B0); PG8_MMA(1, 1, At, B1); PG8_BAR; PG8_SCHED;
            } else {
            PG8_LDB(B0, 0, 0); PG8_SCHED; PG8_LDA(At, 0, 0); PG8_STAGE(PG8_SA(1, 1), a1 + hstep, voffA);
            PG8_WAIT_L(8); PG8_BAR; PG8_WAIT_L(0); PG8_MMA(0, 0, At, B0); PG8_BAR; PG8_SCHED;
            PG8_LDB(B1, 0, 1); PG8_STAGE(PG8_SB(0, 0), b2, voffB);
            PG8_BAR; PG8_WAIT_L(0); PG8_MMA(0, 1, At, B1); PG8_BAR;
            PG8_LDA(At, 0, 1); PG8_STAGE(PG8_SA(0, 0), a2, voffA);
            PG8_BAR; PG8_WAIT_L(0); PG8_MMA(1, 0, At, B0); PG8_BAR; PG8_SCHED;
            PG8_STAGE(PG8_SB(0, 1), b2 + hstep, voffB);
            PG8_WAIT_V(6); PG8_BAR; PG8_MMA(1, 1, At, B1); PG8_BAR;
            PG8_LDB(B0, 1, 0); PG8_SCHED; PG8_LDA(At, 1, 0); PG8_STAGE(PG8_SA(0, 1), a2 + hstep, voffA);
            PG8_WAIT_L(8); PG8_BAR; PG8_WAIT_L(0); PG8_MMA(0, 0, At, B0); PG8_BAR; PG8_SCHED;
            PG8_LDB(B1, 1, 1); PG8_STAGE(PG8_SB(1, 0), b3, voffB);
            PG8_BAR; PG8_WAIT_L(0); PG8_MMA(0, 1, At, B1); PG8_BAR;
            PG8_LDA(At, 1, 1); PG8_STAGE(PG8_SA(1, 0), a3, voffA);
            PG8_BAR; PG8_WAIT_L(0); PG8_MMA(1, 0, At, B0); PG8_BAR; PG8_SCHED;
            PG8_STAGE(PG8_SB(1, 1), b3 + hstep, voffB);
            PG8_WAIT_V(6); PG8_BAR; PG8_MMA(1, 1, At, B1); PG8_BAR;
            }
        }
        if constexpr (ALIGN_EPI) { if (wr == 0) PG8_BAR; }
        if constexpr (!Epi::AFTER_DRAIN) { E(acc, cur, wr, wc, fr, fq); S.done(cur); }
        if (!has_next) break;
#pragma unroll
        for (int a = 0; a < 2; ++a)
#pragma unroll
            for (int b = 0; b < 2; ++b)
#pragma unroll
                for (int m = 0; m < 4; ++m)
#pragma unroll
                    for (int n = 0; n < 2; ++n) acc[a][b][m][n] = (f32x4){0.f, 0.f, 0.f, 0.f};
        cur = nxt; cA = nA; cB = nB; ++ui;
        if constexpr (ALIGN_EPI) { if (wr == 1) PG8_BAR; }
    }
    PG8_WAIT_V(0);
    if constexpr (!ALIGN_EPI) { if (wr == 0) PG8_BAR; }
    PG8_BAR;
    if constexpr (Epi::AFTER_DRAIN) { E.fused(acc, cur, wr, wc, fr, fq, lds, wid, lane); S.done(cur); }
#undef PG8_SA
#undef PG8_SB
#undef PG8_STAGE
#undef PG8_LDA
#undef PG8_LDB
#undef PG8_MMA
#undef PG8_WAIT_V
#undef PG8_WAIT_L
#undef PG8_BAR
#undef PG8_SCHED
}
}
#define GAS __attribute__((address_space(1)))
#define LAS __attribute__((address_space(3)))
typedef unsigned short bf16;
typedef unsigned v4u __attribute__((ext_vector_type(4)));
typedef float f32x4 __attribute__((ext_vector_type(4)));
typedef short bf16x8 __attribute__((ext_vector_type(8)));
typedef GAS unsigned gu32;
typedef GAS unsigned long long gu64;
#define RLX_AGENT __ATOMIC_RELAXED, __HIP_MEMORY_SCOPE_AGENT
#define LDS_WAIT() asm volatile("s_waitcnt lgkmcnt(0)" ::: "memory")
#define VM_WAIT() asm volatile("s_waitcnt vmcnt(0)" ::: "memory")
__device__ __forceinline__ unsigned long long rt() { return __builtin_amdgcn_s_memrealtime(); }
__device__ __forceinline__ unsigned f2bf(float f) { unsigned u = __builtin_bit_cast(unsigned, f); return (u + 0x7fffu + ((u >> 16) & 1u)) >> 16; }
__device__ __forceinline__ unsigned pk2(float lo, float hi) { return f2bf(lo) | (f2bf(hi) << 16); }
#define XB_TMO      128
#define XB_XCNT(j)  (256  + 64 * (j))
#define XB_XSUB(j)  (1280 + 64 * (j))
#define XB_XGEN(j)  (2304 + 64 * (j))
#define XB_TOP      3328
#define XB_TOPGEN   3392
#define XCD_BAR_WORDS 3456
#define XB_SPIN_CAP (1u << 18)

__device__ __forceinline__ unsigned xb_ld(unsigned* p)              { return __hip_atomic_load(p, __ATOMIC_RELAXED, __HIP_MEMORY_SCOPE_AGENT); }
__device__ __forceinline__ unsigned xb_add(unsigned* p, unsigned v) { return __hip_atomic_fetch_add(p, v, __ATOMIC_RELAXED, __HIP_MEMORY_SCOPE_AGENT); }
__device__ __forceinline__ unsigned xb_xcc_id() { return (unsigned)__builtin_amdgcn_s_getreg((3 << 11) | 20) & 0xFu; }
#define XB_SPIN(cond, bar) do { unsigned _sp = 0; while (cond) { __builtin_amdgcn_s_sleep(1); \
    if ((++_sp & 255u) == 0u) { if (xb_ld(&(bar)[XB_TMO])) break; if (_sp > XB_SPIN_CAP) { atomicAdd(&(bar)[XB_TMO], 1u); break; } } } } while (0)

struct XcdBarrier {
    unsigned* bar; unsigned x;
    volatile LAS unsigned* st;
};

__device__ __forceinline__ XcdBarrier xcd_barrier_post(unsigned* bar, volatile LAS unsigned* st) {
    XcdBarrier b; b.bar = bar; b.x = xb_xcc_id(); b.st = st;
    if (threadIdx.x == 0) (void)xb_add(&bar[XB_XCNT(b.x)], 1u);
    return b;
}
__device__ __forceinline__ void xcd_barrier_complete(unsigned* bar, unsigned x, unsigned& nloc, unsigned& nx) {
    const unsigned G = gridDim.x * gridDim.y * gridDim.z;
    unsigned sum, cnt, mine, sp = 0u;
    for (;;) {
        sum = 0u; cnt = 0u; mine = 0u;
#pragma unroll
        for (unsigned j = 0; j < 16; ++j) { const unsigned c = xb_ld(&bar[XB_XCNT(j)]); sum += c; cnt += (c > 0u) ? 1u : 0u; mine = (j == x) ? c : mine; }
        if (sum == G) break;
        __builtin_amdgcn_s_sleep(1);
        if ((++sp & 255u) == 0u) { if (xb_ld(&bar[XB_TMO])) break; if (sp > XB_SPIN_CAP) { atomicAdd(&bar[XB_TMO], 1u); break; } }
    }
    nloc = mine > 0u ? mine : 1u; nx = cnt > 0u ? cnt : 1u;
}

__device__ __forceinline__ void xcd_barrier(const XcdBarrier& b) {
    asm volatile("s_waitcnt vmcnt(0)" ::: "memory");
    __syncthreads();
    if (threadIdx.x == 0) {
        unsigned* bar = b.bar;
        __builtin_amdgcn_s_waitcnt(0);
        unsigned nloc = b.st[0], nx = b.st[1];
        if (nloc == 0u) { xcd_barrier_complete(bar, b.x, nloc, nx); b.st[0] = nloc; b.st[1] = nx; }
        const unsigned old = xb_add(&bar[XB_XSUB(b.x)], 1u);
        const unsigned gen = old / nloc;
        if (old + 1u == (gen + 1u) * nloc) {
            __builtin_amdgcn_fence(__ATOMIC_RELEASE, "agent");
            asm volatile("s_waitcnt vmcnt(0)" ::: "memory");
            const unsigned og = xb_add(&bar[XB_TOP], 1u);
            const unsigned tg = og / nx;
            if (og + 1u == (tg + 1u) * nx) xb_add(&bar[XB_TOPGEN], 1u);
            else XB_SPIN(xb_ld(&bar[XB_TOPGEN]) == tg, bar);
            __builtin_amdgcn_fence(__ATOMIC_ACQUIRE, "agent");
            xb_add(&bar[XB_XGEN(b.x)], 1u);
            asm volatile("s_waitcnt vmcnt(0)" ::: "memory");
        } else {
            XB_SPIN(xb_ld(&bar[XB_XGEN(b.x)]) == gen, bar);
            __builtin_amdgcn_fence(__ATOMIC_ACQUIRE, "agent");
            asm volatile("s_waitcnt vmcnt(0)" ::: "memory");
        }
    }
    __syncthreads();
}

__device__ __forceinline__ float wave_sum(float v) {
#pragma unroll
    for (int o = 1; o < 64; o <<= 1) v += __shfl_xor(v, o);
    return v;
}
constexpr int NWAVES = 8;
constexpr int BATCH = 2, SEQ = 16384, DM = 1024, CTXL = 256, DEPTH = 4;
constexpr int TL = BATCH * SEQ;
constexpr int TC = BATCH * CTXL;
constexpr int TA = TL + TC;
constexpr int EVEN_IN = 3072, ODD_IN = 1536, PQ_N = 2048, NEXP = 16384;
constexpr float EPS = 1e-6f;
constexpr float LOG2E = 1.4426950408889634f;
constexpr float C2 = 0.125f * LOG2E;

constexpr size_t MiB = 1u << 20;
constexpr size_t WS_CTL = 0, CTL_ZERO_BYTES = 1 * MiB;
constexpr size_t WS_MOD = 1 * MiB;
constexpr size_t WS_ROPE = WS_MOD + 512 * 1024;
constexpr size_t WS_LAM = WS_ROPE + 64 * 1024;
constexpr size_t WS_WIE = 2 * MiB;
constexpr size_t WS_WOE = 14 * MiB;
constexpr size_t WS_WIO = 18 * MiB;
constexpr size_t WS_WOO = 24 * MiB;
constexpr size_t WS_WQ = 28 * MiB;
constexpr size_t WS_KEYS = 44 * MiB;
constexpr size_t WS_U = 48 * MiB;
constexpr size_t WS_V = 176 * MiB;
constexpr size_t WS_X = 304 * MiB;
constexpr size_t WS_H = 434 * MiB;
constexpr size_t WS_P = 499 * MiB;
constexpr size_t WS_O = 694 * MiB;
constexpr size_t WS_IDX = 759 * MiB;
constexpr size_t WS_GATE = 776 * MiB;
constexpr size_t WS_END = 793 * MiB;
constexpr int CW_BAR = 4096;

constexpr int RING_OFF = 0, RING_BYTES = 131072;
constexpr int LDSCTL_OFF = 162816, MISC_OFF = LDSCTL_OFF + 320;
constexpr int LDS_BYTES = 163840;

namespace att {
#ifndef MK_PROBE
#define MK_PROBE 0
#endif
#define PROBE_BEGIN(id) unsigned long long pb_##id = 0; if (MK_PROBE == (id) && probe_on) pb_##id = __builtin_readcyclecounter();
#define PROBE_END(id) if (MK_PROBE == (id) && probe_on) probe_acc += __builtin_readcyclecounter() - pb_##id;
typedef short bf16x8 __attribute__((ext_vector_type(8)));
typedef short s16x4 __attribute__((ext_vector_type(4)));
typedef float f32x16 __attribute__((ext_vector_type(16)));
typedef unsigned u32x4 __attribute__((ext_vector_type(4)));
typedef LAS unsigned char* lptr;
constexpr int KROWB = 144, KIMG = 64 * KROWB;
constexpr int ST_BYTES = 2 * KIMG + 64 * 128 * 2;
constexpr int L_WSF = 3 * ST_BYTES, L_RPB = L_WSF + NWAVES * 256, L_Q = L_RPB + 2048, L_END = L_Q + NWAVES * 4096;
static_assert(L_END <= LDSCTL_OFF, "attention LDS");
constexpr float THR = 4.f;
constexpr int PLD = EVEN_IN;

__device__ __forceinline__ int crow(int r, int hi) { return (r & 3) + 8 * (r >> 2) + 4 * hi; }
__device__ __forceinline__ unsigned cvtpk(float lo, float hi) { typedef float f2 __attribute__((ext_vector_type(2))); typedef __bf16 b2 __attribute__((ext_vector_type(2)));
    f2 v = {lo, hi}; b2 b = __builtin_convertvector(v, b2); return __builtin_bit_cast(unsigned, b); }
__device__ __forceinline__ float partner32(float v, int hi) {
    auto rr = __builtin_amdgcn_permlane32_swap(__float_as_uint(v), __float_as_uint(v), false, false);
    return __uint_as_float(hi ? rr[0] : rr[1]);
}
typedef short v4i16_t __attribute__((ext_vector_type(4)));
__device__ __forceinline__ s16x4 vtr(lptr p) { return __builtin_bit_cast(s16x4, __builtin_amdgcn_ds_read_tr16_b64_v4i16((LAS v4i16_t*)p)); }

__device__ __forceinline__ float max3f(float a, float b, float c) { float r; asm("v_max3_f32 %0, %1, %2, %3" : "=v"(r) : "v"(a), "v"(b), "v"(c)); return r; }
__device__ __forceinline__ float max2f(float a, float b) { float r; asm("v_max_f32_e32 %0, %1, %2" : "=v"(r) : "v"(a), "v"(b)); return r; }
__device__ __forceinline__ float rowmax32(f32x16& p0, f32x16& p1, int hi) {
    asm volatile("s_nop 15\n\ts_nop 7" : "+v"(p0), "+v"(p1));
    float a = max3f(p0[0], p0[1], p1[0]), b = max3f(p0[2], p0[3], p1[1]); a = max3f(a, p1[2], p1[3]);
#pragma unroll
    for (int r = 4; r < 16; r += 4) { a = max3f(a, p0[r], p0[r + 1]); b = max3f(b, p0[r + 2], p0[r + 3]); a = max3f(a, p1[r], p1[r + 1]); b = max3f(b, p1[r + 2], p1[r + 3]); }
    const float m = max2f(a, b);
    return max2f(m, partner32(m, hi));
}
template <int NKI, int DV> struct Stager {
    u32x4 kreg[NKI], vreg[DV / 64];
    __device__ __forceinline__ void load(const bf16* P, int ldp, size_t rowbase, int kcol, int vcol, int tid) {
#pragma unroll
        for (int i = 0; i < NKI; ++i) { const int c = tid + 512 * i, row = c / (8 * NKI), ch = c % (8 * NKI);
            kreg[i] = *(const u32x4*)(P + (rowbase + row) * (size_t)ldp + kcol + ch * 8); }
#pragma unroll
        for (int i = 0; i < DV / 64; ++i) { const int c = tid + 512 * i, row = c / (DV / 8), ch = c % (DV / 8);
            vreg[i] = *(const u32x4*)(P + (rowbase + row) * (size_t)ldp + vcol + ch * 8); }
    }
    __device__ __forceinline__ void loadK(const bf16* P, int ldp, size_t rowbase, int kcol, int tid) {
#pragma unroll
        for (int i = 0; i < NKI; ++i) { const int c = tid + 512 * i, row = c / (8 * NKI), ch = c % (8 * NKI);
            kreg[i] = *(const u32x4*)(P + (rowbase + row) * (size_t)ldp + kcol + ch * 8); }
    }
    __device__ __forceinline__ void loadV(const bf16* P, int ldp, size_t rowbase, int vcol, int tid) {
#pragma unroll
        for (int i = 0; i < DV / 64; ++i) { const int c = tid + 512 * i, row = c / (DV / 8), ch = c % (DV / 8);
            vreg[i] = *(const u32x4*)(P + (rowbase + row) * (size_t)ldp + vcol + ch * 8); }
    }
    __device__ __forceinline__ void storeK(lptr kst, int tid) const {
#pragma unroll
        for (int i = 0; i < NKI; ++i) { const int c = tid + 512 * i, row = c / (8 * NKI), ch = c % (8 * NKI);
            *(LAS u32x4*)(kst + (ch >> 3) * KIMG + row * KROWB + (ch & 7) * 16) = kreg[i]; }
    }
    __device__ __forceinline__ void storeV(lptr vst, int tid) const {
#pragma unroll
        for (int i = 0; i < DV / 64; ++i) { const int c = tid + 512 * i, row = c / (DV / 8), ch = c % (DV / 8);
            *(LAS u32x4*)(vst + (ch >> 2) * 4096 + (row >> 3) * 512 + (row & 7) * 64 + (ch & 3) * 16) = vreg[i]; }
    }
    __device__ __forceinline__ void store(lptr st, int tid) const {
#pragma unroll
        for (int i = 0; i < NKI; ++i) { const int c = tid + 512 * i, row = c / (8 * NKI), ch = c % (8 * NKI);
            *(LAS u32x4*)(st + (ch >> 3) * KIMG + row * KROWB + (ch & 7) * 16) = kreg[i]; }
#pragma unroll
        for (int i = 0; i < DV / 64; ++i) { const int c = tid + 512 * i, row = c / (DV / 8), ch = c % (DV / 8);
            *(LAS u32x4*)(st + NKI * KIMG + (ch >> 2) * 4096 + (row >> 3) * 512 + (row & 7) * 64 + (ch & 3) * 16) = vreg[i]; }
    }
};

template <int DV> struct WaveAcc { f32x16 o[DV / 32]; float m, l;
    __device__ __forceinline__ void init() {
#pragma unroll
        for (int c = 0; c < DV / 32; ++c) o[c] = f32x16{};
        m = -INFINITY; l = 0.f; } };

template <int DV> __device__ __forceinline__ void sm_pv(WaveAcc<DV>& A, const u32x4 (&pw)[4], lptr vimg, int lane, int hi) {
    constexpr int NC = DV / 32;
    lptr vp = vimg + (4 * hi + ((lane & 15) >> 2)) * 64 + ((lane >> 4) & 1) * 32 + (lane & 3) * 8;
    bf16x8 f0[NC], f1[NC];
#define PV_READ(F, ks) _Pragma("unroll") for (int c = 0; c < NC; ++c) { const s16x4 lo = vtr(vp + c * 4096 + (ks) * 1024), h2 = vtr(vp + c * 4096 + (ks) * 1024 + 512); F[c] = __builtin_shufflevector(lo, h2, 0, 1, 2, 3, 4, 5, 6, 7); }
#define PV_MMA(F, ks) _Pragma("unroll") for (int c = 0; c < NC; ++c) A.o[c] = __builtin_amdgcn_mfma_f32_32x32x16_bf16(__builtin_bit_cast(bf16x8, pw[ks]), F[c], A.o[c], 0, 0, 0);
    PV_READ(f0, 0) PV_READ(f1, 1)
    __builtin_amdgcn_sched_barrier(0);
    PV_MMA(f0, 0)
    __builtin_amdgcn_sched_barrier(0);
    PV_READ(f0, 2)
    __builtin_amdgcn_sched_barrier(0);
    PV_MMA(f1, 1)
    __builtin_amdgcn_sched_barrier(0);
    PV_READ(f1, 3)
    __builtin_amdgcn_sched_barrier(0);
    PV_MMA(f0, 2)
    PV_MMA(f1, 3)
#undef PV_READ
#undef PV_MMA
}
template <int DV> __device__ __forceinline__ void sm_exp_pv_fused(WaveAcc<DV>& A, f32x16& p0, f32x16& p1, u32x4 (&pw_out)[4], const u32x4 (&pw_in)[4], lptr vimg, int lane, int hi) {
    constexpr int NC = DV / 32;
    constexpr int EPM = 32 / (4 * NC);
    lptr vp = vimg + (4 * hi + ((lane & 15) >> 2)) * 64 + ((lane >> 4) & 1) * 32 + (lane & 3) * 8;
    bf16x8 f0[NC], f1[NC];
#define PV_READ(F, ks) _Pragma("unroll") for (int c = 0; c < NC; ++c) { const s16x4 lo = vtr(vp + c * 4096 + (ks) * 1024), h2 = vtr(vp + c * 4096 + (ks) * 1024 + 512); F[c] = __builtin_shufflevector(lo, h2, 0, 1, 2, 3, 4, 5, 6, 7); }
#define PV_MMA_EXP(F, ks) _Pragma("unroll") for (int c = 0; c < NC; ++c) { \
        A.o[c] = __builtin_amdgcn_mfma_f32_32x32x16_bf16(__builtin_bit_cast(bf16x8, pw_in[ks]), F[c], A.o[c], 0, 0, 0); \
        _Pragma("unroll") for (int e = 0; e < EPM; ++e) { const int idx = ((ks) * NC + c) * EPM + e; if (idx < 16) p0[idx] = __builtin_amdgcn_exp2f(p0[idx]); else p1[idx - 16] = __builtin_amdgcn_exp2f(p1[idx - 16]); } \
        __builtin_amdgcn_sched_barrier(0); }
    PV_READ(f0, 0) PV_READ(f1, 1)
    __builtin_amdgcn_sched_barrier(0);
    PV_MMA_EXP(f0, 0)
    PV_READ(f0, 2)
    __builtin_amdgcn_sched_barrier(0);
    PV_MMA_EXP(f1, 1)
    PV_READ(f1, 3)
    __builtin_amdgcn_sched_barrier(0);
    PV_MMA_EXP(f0, 2)
    PV_MMA_EXP(f1, 3)
#undef PV_READ
#undef PV_MMA_EXP
    float s = 0.f;
#pragma unroll
    for (int r = 0; r < 16; ++r) s += p0[r] + p1[r];
    A.l += s;
#pragma unroll
    for (int k = 0; k < 2; ++k) {
        pw_out[k] = (u32x4){cvtpk(p0[8 * k + 0], p0[8 * k + 1]), cvtpk(p0[8 * k + 2], p0[8 * k + 3]), cvtpk(p0[8 * k + 4], p0[8 * k + 5]), cvtpk(p0[8 * k + 6], p0[8 * k + 7])};
        pw_out[2 + k] = (u32x4){cvtpk(p1[8 * k + 0], p1[8 * k + 1]), cvtpk(p1[8 * k + 2], p1[8 * k + 3]), cvtpk(p1[8 * k + 4], p1[8 * k + 5]), cvtpk(p1[8 * k + 6], p1[8 * k + 7])};
    }
}
__device__ __forceinline__ void qk_tile_rel(f32x16& p0, f32x16& p1, lptr kimg, const bf16x8 (&qr)[4], const f32x16& negm, int r32, int hi) {
    lptr kb = kimg + r32 * KROWB + hi * 16;
    bf16x8 a0[4], a1[4];
#pragma unroll
    for (int d0 = 0; d0 < 4; ++d0) { a0[d0] = *(LAS bf16x8*)(kb + d0 * 32); a1[d0] = *(LAS bf16x8*)(kb + 32 * KROWB + d0 * 32); }
    __builtin_amdgcn_sched_barrier(0);
#pragma unroll
    for (int d0 = 0; d0 < 4; ++d0) {
        p0 = __builtin_amdgcn_mfma_f32_32x32x16_bf16(a0[d0], qr[d0], d0 == 0 ? negm : p0, 0, 0, 0);
        p1 = __builtin_amdgcn_mfma_f32_32x32x16_bf16(a1[d0], qr[d0], d0 == 0 ? negm : p1, 0, 0, 0);
    }
}
template <int DV> __device__ __forceinline__ void sm_max_rel(WaveAcc<DV>& A, f32x16& p0, f32x16& p1, f32x16& negm, bool first, LAS float* wsf, int r32, int hi) {
    const float mx = rowmax32(p0, p1, hi);
    if (first || __any(mx > THR)) {
        const float dl = first ? mx : fmaxf(mx, 0.f);
        const float alpha = __builtin_amdgcn_exp2f(-dl);
        A.l *= alpha; A.m += dl;
#pragma unroll
        for (int r = 0; r < 16; ++r) { p0[r] -= dl; p1[r] -= dl; }
#pragma unroll
        for (int r = 0; r < 16; ++r) negm[r] = -A.m;
        if (hi == 0) wsf[r32] = alpha;
        asm volatile("" ::: "memory");
#pragma unroll
        for (int r = 0; r < 16; ++r) { const float a = wsf[crow(r, hi)];
#pragma unroll
            for (int c = 0; c < DV / 32; ++c) A.o[c][r] *= a; }
    }
}
template <int DV> __device__ __forceinline__ void sm_max_rel_pend(WaveAcc<DV>& A, f32x16& p0, f32x16& p1, f32x16& negm, bool first, u32x4 (&pw)[4], lptr vimg_prev, LAS float* wsf, int lane, int r32, int hi) {
    const float mx = rowmax32(p0, p1, hi);
    if (first || __any(mx > THR)) {
        sm_pv<DV>(A, pw, vimg_prev, lane, hi);
#pragma unroll
        for (int k = 0; k < 4; ++k) pw[k] = (u32x4){0u, 0u, 0u, 0u};
        const float dl = first ? mx : fmaxf(mx, 0.f);
        const float alpha = __builtin_amdgcn_exp2f(-dl);
        A.l *= alpha; A.m += dl;
#pragma unroll
        for (int r = 0; r < 16; ++r) { p0[r] -= dl; p1[r] -= dl; }
#pragma unroll
        for (int r = 0; r < 16; ++r) negm[r] = -A.m;
        if (hi == 0) wsf[r32] = alpha;
        asm volatile("" ::: "memory");
#pragma unroll
        for (int r = 0; r < 16; ++r) { const float a = wsf[crow(r, hi)];
#pragma unroll
            for (int c = 0; c < DV / 32; ++c) A.o[c][r] *= a; }
    }
}
template <int DV> __device__ __forceinline__ void sm_exp_rel(WaveAcc<DV>& A, f32x16& p0, f32x16& p1, u32x4 (&pw)[4]) {
    float s = 0.f;
#pragma unroll
    for (int r = 0; r < 16; ++r) { p0[r] = __builtin_amdgcn_exp2f(p0[r]); p1[r] = __builtin_amdgcn_exp2f(p1[r]); s += p0[r] + p1[r]; }
    A.l += s;
#pragma unroll
    for (int k = 0; k < 2; ++k) {
        pw[k] = (u32x4){cvtpk(p0[8 * k + 0], p0[8 * k + 1]), cvtpk(p0[8 * k + 2], p0[8 * k + 3]), cvtpk(p0[8 * k + 4], p0[8 * k + 5]), cvtpk(p0[8 * k + 6], p0[8 * k + 7])};
        pw[2 + k] = (u32x4){cvtpk(p1[8 * k + 0], p1[8 * k + 1]), cvtpk(p1[8 * k + 2], p1[8 * k + 3]), cvtpk(p1[8 * k + 4], p1[8 * k + 5]), cvtpk(p1[8 * k + 6], p1[8 * k + 7])};
    }
}
__device__ __forceinline__ void inv_rows(float (&invr)[16], float l, float extra, LAS float* wsf, int r32, int hi) {
    const float lt = l + partner32(l, hi) + extra;
    if (hi == 0) wsf[32 + r32] = 1.f / lt;
    __builtin_amdgcn_s_waitcnt(0xc07f); asm volatile("" ::: "memory");
#pragma unroll
    for (int r = 0; r < 16; ++r) invr[r] = wsf[32 + crow(r, hi)];
}
__device__ __forceinline__ void load_q(bf16x8 (&qr)[4], const bf16* P, int ldp, size_t qrow0, int qcol, int r32, int hi) {
#pragma unroll
    for (int d0 = 0; d0 < 4; ++d0) qr[d0] = *(const bf16x8*)(P + (qrow0 + r32) * (size_t)ldp + qcol + d0 * 16 + hi * 8);
}
__device__ __forceinline__ void store_o64(const WaveAcc<64>& A, const float (&invr)[16], bf16* O, size_t qrow0, int ocol, int r32, int hi) {
#pragma unroll
    for (int r = 0; r < 16; ++r)
#pragma unroll
        for (int c = 0; c < 2; ++c) O[(qrow0 + crow(r, hi)) * (size_t)DM + ocol + 32 * c + r32] = (bf16)f2bf(A.o[c][r] * invr[r]);
}

__device__ __forceinline__ void na_unit(bool isctx, int b, int h, int g4, const bf16* P, bf16* O, const float* rpb, LAS unsigned char* lds) {
    int tid = threadIdx.x; asm volatile("" : "+v"(tid));
    const int lane = tid & 63, r32 = lane & 31, hi = lane >> 5, w = __builtin_amdgcn_readfirstlane(tid >> 6);
    LAS float* rpbl = (LAS float*)(lds + L_RPB); LAS float* wsf = (LAS float*)(lds + L_WSF) + w * 64;
    for (int i = tid; i < 15 * 31; i += 512) rpbl[i] = rpb[h * 465 + i] * LOG2E;
    const size_t ctx0 = (size_t)TL + (size_t)b * CTXL;
    const int qgr = 4 * g4 + (w >> 1), qcb = 32 * (w & 1);
    const size_t qrow0 = isctx ? ctx0 + 32 * w : (size_t)b * SEQ + qgr * 64 + qcb;
    bf16x8 qr[4]; load_q(qr, P, EVEN_IN, qrow0, h * 64, r32, hi);
    const int kr_lo = max(4 * g4 - 4, 0), kr_hi = min(max(4 * g4 - 1, 0), 248) + 8;
    const int nt = isctx ? 4 : 4 + (kr_hi - kr_lo);
    const int rs = min(max(qgr - 4, 0), 248);
    const int kcol = 512 + h * 64, vcol = 1024 + h * 64;
    WaveAcc<64> A; A.init(); A.m = 0.f; f32x16 negm = f32x16{};
    Stager<1, 64> sg;
#define NA_ROWBASE(t) ((t) < 4 ? ctx0 + 64 * (t) : (size_t)b * SEQ + (size_t)(kr_lo + (t) - 4) * 64)
    sg.load(P, EVEN_IN, NA_ROWBASE(0), kcol, vcol, tid); sg.store(lds, tid);
    if (nt > 1) sg.load(P, EVEN_IN, NA_ROWBASE(1), kcol, vcol, tid);
    for (int t = 0; t < nt; ++t) {
        __syncthreads();
        if (t + 1 < nt) { sg.store(lds + ((t + 1) & 1) * ST_BYTES, tid); if (t + 2 < nt) sg.load(P, EVEN_IN, NA_ROWBASE(t + 2), kcol, vcol, tid); }
        lptr st = lds + (t & 1) * ST_BYTES;
        const int kr = kr_lo + t - 4;
        if (t < 4 || (kr >= rs && kr < rs + 8)) {
            f32x16 p0, p1; qk_tile_rel(p0, p1, st, qr, negm, r32, hi);
            if (t >= 4) {
                const int qc = qcb + r32; int cs4 = min(max(qc - 8, 0), 48) - 4 * hi;
                asm volatile("" : "+v"(cs4));
                LAS const float* bl = rpbl + (kr - qgr + 7) * 31 + (15 - qc + 4 * hi);
#pragma unroll
                for (int r = 0; r < 16; ++r) {
                    const int kk = (r & 3) + 8 * (r >> 2);
                    p0[r] = ((unsigned)(kk - cs4) < 16u) ? p0[r] + bl[kk] : -INFINITY;
                    p1[r] = ((unsigned)(kk + 32 - cs4) < 16u) ? p1[r] + bl[kk + 32] : -INFINITY;
                }
            }
            sm_max_rel<64>(A, p0, p1, negm, t == 0, wsf, r32, hi);
            u32x4 pw[4]; sm_exp_rel<64>(A, p0, p1, pw);
            sm_pv<64>(A, pw, st + KIMG, lane, hi);
        }
    }
#undef NA_ROWBASE
    float invr[16]; inv_rows(invr, A.l, 0.f, wsf, r32, hi);
    store_o64(A, invr, O, qrow0, h * 64, r32, hi);
    __syncthreads();
}

__device__ __forceinline__ void swa_unit(bool isctx, int b, int n, int qb, const bf16* P, bf16* O, const float* sink, LAS unsigned char* lds) {
    int tid = threadIdx.x; asm volatile("" : "+v"(tid));
    const int lane = tid & 63, r32 = lane & 31, hi = lane >> 5, w = __builtin_amdgcn_readfirstlane(tid >> 6);
    LAS float* wsf = (LAS float*)(lds + L_WSF) + w * 64;
    const size_t ctx0 = (size_t)TL + (size_t)b * CTXL;
    const int hq = 4 * n + (w >> 1), j = w & 1, q0 = 64 * qb;
    const size_t qrow0 = isctx ? ctx0 + q0 + 32 * j : (size_t)b * SEQ + q0 + 32 * j;
    bf16x8 qr[4]; load_q(qr, P, ODD_IN, qrow0, hq * 64, r32, hi);
    const int jlo = q0 >= 128 ? 0 : (128 - q0) / 64, jhi = min(5, (SEQ - q0 + 128) / 64);
    const int nt = isctx ? 4 : 4 + (jhi - jlo);
    const int kcol = 1024 + n * 64, vcol = 1280 + n * 64;
    WaveAcc<64> A; A.init(); A.m = 0.f; f32x16 negm = f32x16{};
    Stager<1, 64> sg;
#define SWA_KPOS0(t) (q0 - 128 + 64 * (jlo + (t) - 4))
#define SWA_ROWBASE(t) ((t) < 4 ? ctx0 + 64 * (t) : (size_t)b * SEQ + (size_t)SWA_KPOS0(t))
    sg.load(P, ODD_IN, SWA_ROWBASE(0), kcol, vcol, tid); sg.store(lds, tid);
    if (nt > 1) sg.load(P, ODD_IN, SWA_ROWBASE(1), kcol, vcol, tid);
    for (int t = 0; t < nt; ++t) {
        __syncthreads();
        if (t + 1 < nt) { sg.store(lds + ((t + 1) & 1) * ST_BYTES, tid); if (t + 2 < nt) sg.load(P, ODD_IN, SWA_ROWBASE(t + 2), kcol, vcol, tid); }
        lptr st = lds + (t & 1) * ST_BYTES;
        f32x16 p0, p1; qk_tile_rel(p0, p1, st, qr, negm, r32, hi);
        if (t >= 4) {
            const int dbase = SWA_KPOS0(t) - (q0 + 32 * j + r32) + 128;
#pragma unroll
            for (int r = 0; r < 16; ++r) {
                const int k0 = crow(r, hi);
                p0[r] = ((unsigned)(dbase + k0) <= 256u) ? p0[r] : -INFINITY;
                p1[r] = ((unsigned)(dbase + k0 + 32) <= 256u) ? p1[r] : -INFINITY;
            }
        }
        sm_max_rel<64>(A, p0, p1, negm, t == 0, wsf, r32, hi);
        u32x4 pw[4]; sm_exp_rel<64>(A, p0, p1, pw);
        sm_pv<64>(A, pw, st + KIMG, lane, hi);
    }
#undef SWA_ROWBASE
#undef SWA_KPOS0
    float invr[16]; inv_rows(invr, A.l, __builtin_amdgcn_exp2f(sink[hq] * LOG2E - A.m), wsf, r32, hi);
    store_o64(A, invr, O, qrow0, hq * 64, r32, hi);
    __syncthreads();
}

__device__ __forceinline__ void diff_unit(bool isctx, int b, int h, int qb, const bf16* P, bf16* O, float lam, float osc, const float* subg, LAS unsigned char* lds, unsigned long long& probe_acc) {
    const bool probe_on = MK_PROBE != 0 && blockIdx.x == 0 && __builtin_amdgcn_readfirstlane(threadIdx.x >> 6) == 0;
    int tid = threadIdx.x; asm volatile("" : "+v"(tid));
    const int lane = tid & 63, r32 = lane & 31, hi = lane >> 5, w = __builtin_amdgcn_readfirstlane(tid >> 6);
    LAS float* wsf = (LAS float*)(lds + L_WSF) + w * 64;
    const size_t ctx0 = (size_t)TL + (size_t)b * CTXL;
    const int mp = w >> 2, qg = w & 3;
    const size_t qrow0 = (isctx ? ctx0 : (size_t)b * SEQ) + 128 * qb + 32 * qg;
    bf16x8 qr[4]; load_q(qr, P, EVEN_IN, qrow0, 1536 + h * 128 + mp * 64, r32, hi);
    const int nt = isctx ? 4 : 4 + SEQ / 64;
    const int kcol = 2048 + h * 128, vcol = 2560 + h * 128;
    WaveAcc<128> A; A.init();
    Stager<2, 128> sg;
#define DF_ROWBASE(t) ((t) < 4 ? ctx0 + 64 * (t) : (size_t)b * SEQ + (size_t)((t) - 4) * 64)
    A.m = 0.f; f32x16 negm = f32x16{};
    sg.load(P, EVEN_IN, DF_ROWBASE(0), kcol, vcol, tid); sg.store(lds, tid);
    sg.load(P, EVEN_IN, DF_ROWBASE(1), kcol, vcol, tid);
    u32x4 pw[4] = {};
    int s_prev = 2 * ST_BYTES, s_cur = 0, s_nxt = ST_BYTES;
    for (int t = 0; t < nt; ++t) {
        __syncthreads();
        if (t + 1 < nt) { sg.store(lds + s_nxt, tid); if (t + 2 < nt) sg.load(P, EVEN_IN, DF_ROWBASE(t + 2), kcol, vcol, tid); }
        f32x16 p0, p1; qk_tile_rel(p0, p1, lds + s_cur + mp * KIMG, qr, negm, r32, hi);
        lptr vprev = lds + (t == 0 ? s_cur : s_prev) + 2 * KIMG;
        sm_max_rel_pend<128>(A, p0, p1, negm, t == 0, pw, vprev, wsf, lane, r32, hi);
        u32x4 pwn[4]; sm_exp_pv_fused<128>(A, p0, p1, pwn, pw, vprev, lane, hi);
#pragma unroll
        for (int k = 0; k < 4; ++k) pw[k] = pwn[k];
        const int tmp = s_prev; s_prev = s_cur; s_cur = s_nxt; s_nxt = tmp;
    }
    sm_pv<128>(A, pw, lds + s_prev + 2 * KIMG, lane, hi);
#undef DF_ROWBASE
    float invr[16]; inv_rows(invr, A.l, 0.f, wsf, r32, hi);
    __syncthreads();
    LAS float* xch = (LAS float*)lds + qg * 4096;
    if (mp == 1) {
#pragma unroll
        for (int r = 0; r < 16; ++r)
#pragma unroll
            for (int c = 0; c < 4; ++c) xch[crow(r, hi) * 128 + 32 * c + r32] = A.o[c][r] * invr[r];
    }
    __syncthreads();
    if (mp == 0) {
        float gsub[4];
#pragma unroll
        for (int c = 0; c < 4; ++c) gsub[c] = subg[32 * c + r32] * osc;
#pragma unroll
        for (int r = 0; r < 16; ++r) {
            float ss = 0.f;
#pragma unroll
            for (int c = 0; c < 4; ++c) { const float v = A.o[c][r] * invr[r] - lam * xch[crow(r, hi) * 128 + 32 * c + r32]; A.o[c][r] = v; ss += v * v; }
#pragma unroll
            for (int o = 1; o < 32; o <<= 1) ss += __shfl_xor(ss, o);
            const float rs = __builtin_amdgcn_rsqf(ss * (1.f / 128.f) + EPS);
#pragma unroll
            for (int c = 0; c < 4; ++c) O[(qrow0 + crow(r, hi)) * (size_t)DM + 512 + h * 128 + 32 * c + r32] = (bf16)f2bf(A.o[c][r] * rs * gsub[c]);
        }
    }
    __syncthreads();
}
}

namespace peer {
typedef short bf16x8 __attribute__((ext_vector_type(8)));
typedef float f32x16 __attribute__((ext_vector_type(16)));
typedef unsigned u32x4 __attribute__((ext_vector_type(4)));
constexpr int KEYROWB = 272, KEYIMG = 128 * KEYROWB;
constexpr int L_KEYS = 0, L_TAB = 2 * KEYIMG;
static_assert(L_TAB + NWAVES * 2048 <= RING_BYTES, "peer LDS");

__device__ __forceinline__ void cex(float& a, float& b) { const float mx = fmaxf(a, b), mn = fminf(a, b); a = mx; b = mn; }
template <int OFF> __device__ __forceinline__ void sort16(float (&v)[64]) {
#pragma unroll
    for (int k = 2; k <= 16; k <<= 1)
#pragma unroll
        for (int j = k >> 1; j > 0; j >>= 1)
#pragma unroll
            for (int i = 0; i < 16; ++i) { const int l = i ^ j; if (l > i) { if ((i & k) == 0) cex(v[OFF + i], v[OFF + l]); else cex(v[OFF + l], v[OFF + i]); } }
}
__device__ __forceinline__ void merge16(float (&t)[16]) {
#pragma unroll
    for (int j = 8; j > 0; j >>= 1)
#pragma unroll
        for (int i = 0; i < 16; ++i) { const int l = i ^ j; if (l > i) cex(t[i], t[l]); }
}
__device__ __forceinline__ void top16_of_64(float (&v)[64], float (&out)[16]) {
    sort16<0>(v); sort16<16>(v); sort16<32>(v); sort16<48>(v);
    float a[16], b[16];
#pragma unroll
    for (int i = 0; i < 16; ++i) { a[i] = fmaxf(v[i], v[31 - i]); b[i] = fmaxf(v[32 + i], v[63 - i]); }
    merge16(a); merge16(b);
#pragma unroll
    for (int i = 0; i < 16; ++i) out[i] = fmaxf(a[i], b[15 - i]);
    merge16(out);
}
struct CandTab { int pos[16][16]; int n;
    constexpr CandTab() : pos{}, n(0) { for (int x = 0; x < 16; ++x) for (int y = 0; y < 16; ++y) { pos[x][y] = n; if ((x + 1) * (y + 1) <= 16) ++n; } } };
constexpr CandTab CT{};
static_assert(CT.n == 50, "50 candidate pairs");
template <int A, int B> struct CandPos { static constexpr int value = CT.pos[A][B]; };

template <int A, int B> __device__ __forceinline__ void cand_fill(float (&c)[64], const float (&top)[2][16]) {
    if constexpr ((A + 1) * (B + 1) <= 16) {
        const float s = __uint_as_float(__float_as_uint(top[0][A]) & ~127u) + __uint_as_float(__float_as_uint(top[1][B]) & ~127u);
        c[CT.pos[A][B]] = __uint_as_float((__float_as_uint(s) & ~255u) | (unsigned)(A * 16 + B));
    }
    if constexpr (B < 15) cand_fill<A, B + 1>(c, top);
    else if constexpr (A < 15) cand_fill<A + 1, 0>(c, top);
}
__device__ __forceinline__ void topk_wave(const bf16* PQ, size_t tok0, int h, LAS unsigned char* keys, LAS unsigned* tab, int* IDX, float* GATE, int lane) {
    const int r32 = lane & 31, hi = lane >> 5;
    float top[2][16];
#pragma unroll
    for (int p = 0; p < 2; ++p) {
        bf16x8 qf[8];
#pragma unroll
        for (int ks = 0; ks < 8; ++ks) qf[ks] = *(const bf16x8*)(PQ + (tok0 + r32) * (size_t)PQ_N + h * 256 + p * 128 + ks * 16 + hi * 8);
        float v[64];
#pragma unroll
        for (int nb = 0; nb < 4; ++nb) {
            f32x16 acc = f32x16{};
            LAS unsigned char* kb = keys + p * KEYIMG + (32 * nb + r32) * KEYROWB + hi * 16;
#pragma unroll
            for (int ks = 0; ks < 8; ++ks) acc = __builtin_amdgcn_mfma_f32_32x32x16_bf16(*(LAS bf16x8*)(kb + ks * 32), qf[ks], acc, 0, 0, 0);
#pragma unroll
            for (int r = 0; r < 16; ++r) { const unsigned n = 32 * nb + (r & 3) + 8 * (r >> 2) + 4 * hi; v[16 * nb + r] = __uint_as_float((__float_as_uint(acc[r]) & ~127u) | n); }
        }
        float mine[16]; top16_of_64(v, mine);
#pragma unroll
        for (int i = 0; i < 16; ++i) { const float o = att::partner32(mine[15 - i], hi); top[p][i] = fmaxf(mine[i], o); }
        merge16(top[p]);
    }
#pragma unroll
    for (int p = 0; p < 2; ++p)
#pragma unroll
        for (int j = 0; j < 4; ++j) {
            unsigned wv = 0;
#pragma unroll
            for (int e = 0; e < 4; ++e) wv |= (__float_as_uint(top[p][4 * j + e]) & 127u) << (8 * e);
            tab[(4 * p + j) * 64 + lane] = wv;
        }
    float c[64];
#pragma unroll
    for (int i = 0; i < 64; ++i) c[i] = -INFINITY;
    cand_fill<0, 0>(c, top);
    float res[16]; top16_of_64(c, res);
    float fv[16]; int eid[16];
    float mx = -INFINITY;
#pragma unroll
    for (int k = 0; k < 16; ++k) {
        const unsigned bits = __float_as_uint(res[k]); const unsigned a = (bits >> 4) & 15u, b = bits & 15u;
        const unsigned w1 = tab[(a >> 2) * 64 + lane], w2 = tab[(4 + (b >> 2)) * 64 + lane];
        const unsigned i1 = (w1 >> (8 * (a & 3))) & 127u, i2 = (w2 >> (8 * (b & 3))) & 127u;
        eid[k] = (int)(i1 * 128u + i2); fv[k] = __uint_as_float(bits & ~255u); mx = fmaxf(mx, fv[k]);
    }
    float sum = 0.f;
#pragma unroll
    for (int k = 0; k < 16; ++k) { fv[k] = __builtin_amdgcn_exp2f((fv[k] - mx) * LOG2E); sum += fv[k]; }
    const float inv = 1.f / sum;
    int* ip = IDX + (tok0 + r32) * 128 + h * 16; float* gp = GATE + (tok0 + r32) * 128 + h * 16;
#pragma unroll
    for (int k = 0; k < 16; ++k) fv[k] *= inv;
    if (hi == 0) {
        *(int4*)(ip) = make_int4(eid[0], eid[1], eid[2], eid[3]); *(int4*)(ip + 4) = make_int4(eid[4], eid[5], eid[6], eid[7]);
        *(float4*)(gp) = make_float4(fv[0], fv[1], fv[2], fv[3]); *(float4*)(gp + 4) = make_float4(fv[4], fv[5], fv[6], fv[7]);
    } else {
        *(int4*)(ip + 8) = make_int4(eid[8], eid[9], eid[10], eid[11]); *(int4*)(ip + 12) = make_int4(eid[12], eid[13], eid[14], eid[15]);
        *(float4*)(gp + 8) = make_float4(fv[8], fv[9], fv[10], fv[11]); *(float4*)(gp + 12) = make_float4(fv[12], fv[13], fv[14], fv[15]);
    }
}

__device__ __forceinline__ float gelu_f(float v) {
    const float av = fabsf(v), t = __builtin_amdgcn_rcpf(av * 0.2316418882f + 1.0f);
    float q = t * 0.5307027145f + (-0.7265760135f); q = q * t + 0.7107068705f; q = q * t + (-0.142248368f); q = q * t + 0.127414796f; q = q * t;
    const float e = __builtin_amdgcn_exp2f((v * v) * (-0.72134752044f));
    const float m = v * (q * e);
    return v < 0.f ? m : v - m;
}
typedef float f2 __attribute__((ext_vector_type(2)));
constexpr float U4_SCALE = 64.f, V4_SCALE = 8.f;
__device__ __forceinline__ void expert_token4(const bf16* Hrow, const int* idx, const float* gate, const unsigned char* UV4, f2 (&f)[8], int lane) {
    f2 hv[8];
    { const u32x4 h0 = *(const u32x4*)(Hrow + 16 * lane), h1 = *(const u32x4*)(Hrow + 16 * lane + 8);
      const unsigned hw[8] = {h0.x, h0.y, h0.z, h0.w, h1.x, h1.y, h1.z, h1.w};
#pragma unroll
      for (int i = 0; i < 8; ++i) hv[i] = (f2){__uint_as_float(hw[i] << 16), __uint_as_float(hw[i] & 0xffff0000u)}; }
    const int i0 = idx[lane], i1 = idx[64 + lane];
    const float g0 = gate[lane], g1 = gate[64 + lane];
#pragma unroll
    for (int i = 0; i < 8; ++i) f[i] = (f2){0.f, 0.f};
#pragma nounroll
    for (int g = 0; g < 8; ++g) {
        const int ireg = g < 4 ? i0 : i1; const float greg = g < 4 ? g0 : g1;
        u32x4 rq[16];
#pragma unroll
        for (int k = 0; k < 16; ++k) { const unsigned e = (unsigned)__builtin_amdgcn_readlane(ireg, (g * 16 + k) & 63); rq[k] = *(const u32x4*)(UV4 + ((size_t)e * 64 + lane) * 16); }
        float d[16];
#pragma unroll
        for (int k = 0; k < 16; ++k) { const unsigned w0 = rq[k].x, w1 = rq[k].y;
            f2 a = hv[0] * __builtin_amdgcn_cvt_scalef32_pk_f32_fp4(w0, 1.0f, 0);
            a += hv[1] * __builtin_amdgcn_cvt_scalef32_pk_f32_fp4(w0, 1.0f, 1);
            a += hv[2] * __builtin_amdgcn_cvt_scalef32_pk_f32_fp4(w0, 1.0f, 2);
            a += hv[3] * __builtin_amdgcn_cvt_scalef32_pk_f32_fp4(w0, 1.0f, 3);
            a += hv[4] * __builtin_amdgcn_cvt_scalef32_pk_f32_fp4(w1, 1.0f, 0);
            a += hv[5] * __builtin_amdgcn_cvt_scalef32_pk_f32_fp4(w1, 1.0f, 1);
            a += hv[6] * __builtin_amdgcn_cvt_scalef32_pk_f32_fp4(w1, 1.0f, 2);
            a += hv[7] * __builtin_amdgcn_cvt_scalef32_pk_f32_fp4(w1, 1.0f, 3);
            d[k] = a.x + a.y; }
        float d8[8];
#pragma unroll
        for (int k = 0; k < 8; ++k) { const bool up = (lane & 32) != 0; const float keep = up ? d[8 + k] : d[k], send = up ? d[k] : d[8 + k]; d8[k] = keep + __shfl_xor(send, 32); }
        float d4[4];
#pragma unroll
        for (int k = 0; k < 4; ++k) { const bool up = (lane & 16) != 0; const float keep = up ? d8[4 + k] : d8[k], send = up ? d8[k] : d8[4 + k]; d4[k] = keep + __shfl_xor(send, 16); }
        float d2[2];
#pragma unroll
        for (int k = 0; k < 2; ++k) { const bool up = (lane & 8) != 0; const float keep = up ? d4[2 + k] : d4[k], send = up ? d4[k] : d4[2 + k]; d2[k] = keep + __shfl_xor(send, 8); }
        float d1; { const bool up = (lane & 4) != 0; const float keep = up ? d2[1] : d2[0], send = up ? d2[0] : d2[1]; d1 = keep + __shfl_xor(send, 4); }
        d1 += __shfl_xor(d1, 2); d1 += __shfl_xor(d1, 1);
        const float gk = __shfl(greg, (g * 16 + ((lane >> 2) & 15)) & 63);
        const float wv = gk * gelu_f(d1 * (1.f / U4_SCALE)) * (1.f / V4_SCALE);
#pragma unroll
        for (int k = 0; k < 16; ++k) { const float wk = __uint_as_float(__builtin_amdgcn_readlane(__float_as_uint(wv), 4 * k)); const f2 ww = {wk, wk};
            const unsigned w0 = rq[k].z, w1 = rq[k].w;
            f[0] += ww * __builtin_amdgcn_cvt_scalef32_pk_f32_fp4(w0, 1.0f, 0); f[1] += ww * __builtin_amdgcn_cvt_scalef32_pk_f32_fp4(w0, 1.0f, 1);
            f[2] += ww * __builtin_amdgcn_cvt_scalef32_pk_f32_fp4(w0, 1.0f, 2); f[3] += ww * __builtin_amdgcn_cvt_scalef32_pk_f32_fp4(w0, 1.0f, 3);
            f[4] += ww * __builtin_amdgcn_cvt_scalef32_pk_f32_fp4(w1, 1.0f, 0); f[5] += ww * __builtin_amdgcn_cvt_scalef32_pk_f32_fp4(w1, 1.0f, 1);
            f[6] += ww * __builtin_amdgcn_cvt_scalef32_pk_f32_fp4(w1, 1.0f, 2); f[7] += ww * __builtin_amdgcn_cvt_scalef32_pk_f32_fp4(w1, 1.0f, 3); }
    }
}
}

struct Frame {
    LAS unsigned char* lds;
    int tid, lane, wave, vcu, G;
};
__device__ __forceinline__ void p0_transpose_item(const float* W, int K, int N, bf16* WT, LAS float* scr, int item, int lane) {
    const int nblk = N / 32, kb = item / nblk, nb = item % nblk, k0 = 64 * kb, n0 = 32 * nb;
#pragma unroll 8
    for (int i = 0; i < 32; ++i) { const int kk = 2 * i + (lane >> 5); scr[kk * 33 + (lane & 31)] = W[(size_t)(k0 + kk) * N + n0 + (lane & 31)]; }
    LDS_WAIT(); asm volatile("" ::: "memory");
    const int c = lane & 7;
#pragma unroll
    for (int j = 0; j < 4; ++j) { const int n = (lane >> 3) + 8 * j; const LAS float* s = scr + (8 * c) * 33 + n;
        v4u o; o.x = pk2(s[0 * 33], s[1 * 33]); o.y = pk2(s[2 * 33], s[3 * 33]); o.z = pk2(s[4 * 33], s[5 * 33]); o.w = pk2(s[6 * 33], s[7 * 33]);
        *(GAS v4u*)(WT + (size_t)(n0 + n) * K + k0 + 8 * c) = o; }
    LDS_WAIT(); asm volatile("" ::: "memory");
}
__device__ __forceinline__ void cvt_copy(const float* src, bf16* dst, size_t n8, size_t gtid, size_t nthr) {
    for (size_t i = gtid; i < n8; i += nthr) {
        const f32x4 a = *(const f32x4*)(src + i * 8), b = *(const f32x4*)(src + i * 8 + 4);
        v4u o; o.x = pk2(a.x, a.y); o.y = pk2(a.z, a.w); o.z = pk2(b.x, b.y); o.w = pk2(b.z, b.w);
        *(v4u*)(dst + i * 8) = o;
    }
}
__device__ __forceinline__ void cvt_fp4(const float* U, const float* V, unsigned char* dst, size_t nblk, float su, float sv, size_t gtid, size_t nthr) {
    for (size_t i = gtid; i < nblk; i += nthr) {
        unsigned w[4] = {0u, 0u, 0u, 0u};
#pragma unroll
        for (int q = 0; q < 4; ++q) { const f32x4 a = *(const f32x4*)(U + i * 16 + q * 4) * su, b = *(const f32x4*)(V + i * 16 + q * 4) * sv;
            if (q == 0) { w[0] = __builtin_amdgcn_cvt_scalef32_pk_fp4_f32(w[0], a.x, a.y, 1.0f, 0); w[0] = __builtin_amdgcn_cvt_scalef32_pk_fp4_f32(w[0], a.z, a.w, 1.0f, 1);
                          w[2] = __builtin_amdgcn_cvt_scalef32_pk_fp4_f32(w[2], b.x, b.y, 1.0f, 0); w[2] = __builtin_amdgcn_cvt_scalef32_pk_fp4_f32(w[2], b.z, b.w, 1.0f, 1); }
            if (q == 1) { w[0] = __builtin_amdgcn_cvt_scalef32_pk_fp4_f32(w[0], a.x, a.y, 1.0f, 2); w[0] = __builtin_amdgcn_cvt_scalef32_pk_fp4_f32(w[0], a.z, a.w, 1.0f, 3);
                          w[2] = __builtin_amdgcn_cvt_scalef32_pk_fp4_f32(w[2], b.x, b.y, 1.0f, 2); w[2] = __builtin_amdgcn_cvt_scalef32_pk_fp4_f32(w[2], b.z, b.w, 1.0f, 3); }
            if (q == 2) { w[1] = __builtin_amdgcn_cvt_scalef32_pk_fp4_f32(w[1], a.x, a.y, 1.0f, 0); w[1] = __builtin_amdgcn_cvt_scalef32_pk_fp4_f32(w[1], a.z, a.w, 1.0f, 1);
                          w[3] = __builtin_amdgcn_cvt_scalef32_pk_fp4_f32(w[3], b.x, b.y, 1.0f, 0); w[3] = __builtin_amdgcn_cvt_scalef32_pk_fp4_f32(w[3], b.z, b.w, 1.0f, 1); }
            if (q == 3) { w[1] = __builtin_amdgcn_cvt_scalef32_pk_fp4_f32(w[1], a.x, a.y, 1.0f, 2); w[1] = __builtin_amdgcn_cvt_scalef32_pk_fp4_f32(w[1], a.z, a.w, 1.0f, 3);
                          w[3] = __builtin_amdgcn_cvt_scalef32_pk_fp4_f32(w[3], b.x, b.y, 1.0f, 2); w[3] = __builtin_amdgcn_cvt_scalef32_pk_fp4_f32(w[3], b.z, b.w, 1.0f, 3); }
        }
        *(v4u*)(dst + i * 16) = (v4u){w[0], w[1], w[2], w[3]};
    }
}
__device__ __forceinline__ float silu_f(float x) { return x / (1.f + __expf(-x)); }

struct Args { const float* in[21]; float* out; unsigned char* ws; int ph_lo, ph_hi; };
static_assert(offsetof(Args, out) == 168 && offsetof(Args, ws) == 176 && sizeof(Args) == 192, "kernarg offsets used by INP / WSL");
enum { IN_X = 0, IN_C, IN_CTX, IN_CCTX, IN_WMOD, IN_BMOD, IN_N1G, IN_N2G, IN_WIE, IN_WOE, IN_RPB, IN_DLAM, IN_SUBG, IN_WIO, IN_WOO, IN_SINK, IN_WQ, IN_KEYS, IN_U, IN_V, IN_FG };

__device__ __forceinline__ void norm_row_x2(const float* xa, const float* xb, const float* g, const float* ma_scale, const float* ma_shift, const float* mb_scale, const float* mb_shift, bf16* oa, bf16* ob, int lane) {
    const f32x4* pa = (const f32x4*)xa + lane; const f32x4* pb = (const f32x4*)xb + lane;
    f32x4 va[4], vb[4]; float sa = 0.f, sb = 0.f;
#pragma unroll
    for (int j = 0; j < 4; ++j) { va[j] = pa[64 * j]; vb[j] = pb[64 * j]; }
#pragma unroll
    for (int j = 0; j < 4; ++j) { sa += (va[j].x * va[j].x + va[j].y * va[j].y) + (va[j].z * va[j].z + va[j].w * va[j].w); sb += (vb[j].x * vb[j].x + vb[j].y * vb[j].y) + (vb[j].z * vb[j].z + vb[j].w * vb[j].w); }
#pragma unroll
    for (int o = 1; o < 64; o <<= 1) { sa += __shfl_xor(sa, o); sb += __shfl_xor(sb, o); }
    const float ra = __builtin_amdgcn_rsqf(sa * (1.f / DM) + EPS), rb = __builtin_amdgcn_rsqf(sb * (1.f / DM) + EPS);
#pragma unroll
    for (int j = 0; j < 4; ++j) {
        const f32x4 gg = ((const f32x4*)g)[lane + 64 * j];
        const f32x4 ya = va[j] * ra * gg * (((const f32x4*)ma_scale)[lane + 64 * j] + 1.f) + ((const f32x4*)ma_shift)[lane + 64 * j];
        const f32x4 yb = vb[j] * rb * gg * (((const f32x4*)mb_scale)[lane + 64 * j] + 1.f) + ((const f32x4*)mb_shift)[lane + 64 * j];
        ((unsigned long long*)oa)[lane + 64 * j] = (unsigned long long)pk2(ya.x, ya.y) | ((unsigned long long)pk2(ya.z, ya.w) << 32);
        ((unsigned long long*)ob)[lane + 64 * j] = (unsigned long long)pk2(yb.x, yb.y) | ((unsigned long long)pk2(yb.z, yb.w) << 32);
    }
}
template <int MODE> __device__ __forceinline__ void norm_row(const float* xrow, const float* g, const float* scale, const float* shift, bf16* ob, float* of, int lane) {
    const f32x4* xr = (const f32x4*)xrow + lane;
    f32x4 v[4]; float s = 0.f;
#pragma unroll
    for (int j = 0; j < 4; ++j) { v[j] = xr[64 * j]; s += (v[j].x * v[j].x + v[j].y * v[j].y) + (v[j].z * v[j].z + v[j].w * v[j].w); }
    const float rstd = __builtin_amdgcn_rsqf(wave_sum(s) * (1.f / DM) + EPS);
#pragma unroll
    for (int j = 0; j < 4; ++j) {
        const f32x4 gg = ((const f32x4*)g)[lane + 64 * j];
        f32x4 y = v[j] * rstd * gg;
        if (MODE == 0) {
            const f32x4 sc = ((const f32x4*)scale)[lane + 64 * j], sh = ((const f32x4*)shift)[lane + 64 * j];
            y = y * (sc + 1.f) + sh;
            ((unsigned long long*)ob)[lane + 64 * j] = (unsigned long long)pk2(y.x, y.y) | ((unsigned long long)pk2(y.z, y.w) << 32);
        } else ((f32x4*)of)[lane + 64 * j] = y;
    }
}
constexpr int NPHASES = 2 + 8 * DEPTH;
#ifndef MK_PER_PHASE
#define MK_PER_PHASE 0
#endif
#ifndef MK_KINDS
#define MK_KINDS 0x3FF
#endif
#define KIND_EN(c) (((MK_KINDS) >> (c)) & 1)
#ifndef MK_REPEAT
#define MK_REPEAT 0
#endif
#ifndef MK_SKIP
#define MK_SKIP 0
#endif

__global__ void __launch_bounds__(NWAVES * 64, 2) fwd(Args args) {
    extern __shared__ __attribute__((aligned(16))) unsigned char lds_raw[];
    Frame F;
    F.lds = (LAS unsigned char*)lds_raw;
    F.tid = threadIdx.x; F.lane = F.tid & 63; F.wave = __builtin_amdgcn_readfirstlane(F.tid >> 6);
    F.G = gridDim.x; { const int bx = blockIdx.x; F.vcu = (F.G % 8 == 0) ? (bx % 8) * (F.G / 8) + bx / 8 : bx; }
    unsigned char* ws = args.ws;
    gu32* ctl = (gu32*)(ws + WS_CTL);
    for (int u = F.tid; u < (LDS_BYTES - LDSCTL_OFF) / 4; u += NWAVES * 64) ((LAS unsigned*)(F.lds + LDSCTL_OFF))[u] = 0u;
    __syncthreads();
    XcdBarrier bar = xcd_barrier_post((unsigned*)ctl + CW_BAR, (volatile LAS unsigned*)(F.lds + MISC_OFF) + 8);

typedef const float* cfptr_t; typedef float* fptr_t; typedef unsigned char* ucptr_t;
typedef __attribute__((address_space(4))) const unsigned char* kargp_t;
#define KARG(T, off) (*(__attribute__((address_space(4))) const T*)(kp_ + (off)))
#define INP(i) ((const float*)(const GAS float*)KARG(cfptr_t, 8 * (i)))
#define WSL kargp_t kp_ = (kargp_t)__builtin_amdgcn_kernarg_segment_ptr(); asm volatile("" : "+s"(kp_)); GAS unsigned char* wsl = (GAS unsigned char*)KARG(ucptr_t, 176); int lane = threadIdx.x & 63; asm volatile("" : "+v"(lane)); (void)lane
#define MOD ((float*)(GAS float*)(wsl + WS_MOD))
#define ROPE ((float*)(GAS float*)(wsl + WS_ROPE))
#define LAM ((float*)(GAS float*)(wsl + WS_LAM))
#define WIE ((bf16*)(GAS bf16*)(wsl + WS_WIE))
#define WOE ((bf16*)(GAS bf16*)(wsl + WS_WOE))
#define WIO ((bf16*)(GAS bf16*)(wsl + WS_WIO))
#define WOO ((bf16*)(GAS bf16*)(wsl + WS_WOO))
#define WQ ((bf16*)(GAS bf16*)(wsl + WS_WQ))
#define KEYS ((bf16*)(GAS bf16*)(wsl + WS_KEYS))
#define UB ((bf16*)(GAS bf16*)(wsl + WS_U))
#define VB ((bf16*)(GAS bf16*)(wsl + WS_V))
#define X ((float*)(GAS float*)(wsl + WS_X))
#define H ((bf16*)(GAS bf16*)(wsl + WS_H))
#define P ((bf16*)(GAS bf16*)(wsl + WS_P))
#define O ((bf16*)(GAS bf16*)(wsl + WS_O))
#define PQ ((bf16*)(GAS bf16*)(wsl + WS_P))
#define IDX ((int*)(GAS int*)(wsl + WS_IDX))
#define GATE ((float*)(GAS float*)(wsl + WS_GATE))
    const int lo = args.ph_lo, hi = args.ph_hi;
    unsigned long long probe_acc = 0;
    const int lane = F.lane, wave = F.wave, tid = F.tid, G = F.G, vcu = F.vcu;
    const int gw = vcu * NWAVES + wave, NGW = G * NWAVES;
#define IN(k) (lo <= (k) && (k) < hi)
#define SEAM(k) do { if (IN(k) && IN((k) + 1)) xcd_barrier(bar); } while (0)
#define KPROBE_ON (MK_PROBE != 0 && blockIdx.x == 0 && wave == 0)
#define KP_BEGIN(id) unsigned long long kp_##id = 0; if (MK_PROBE == (id) && KPROBE_ON) kp_##id = __builtin_readcyclecounter();
#define KP_END(id) if (MK_PROBE == (id) && KPROBE_ON) probe_acc += __builtin_readcyclecounter() - kp_##id;

    { KP_BEGIN(18)
    if (KIND_EN(8) && IN(0)) { WSL;
        LAS float* scr = (LAS float*)(F.lds + wave * 16384);
        constexpr int I_IE = 16 * 96, I_OE = 16 * 32, I_IO = 16 * 48, I_OO = 16 * 32, I_WQ = 16 * 64;
        constexpr int NIT = 2 * I_IE + 2 * I_OE + 2 * I_IO + 2 * I_OO + 4 * I_WQ;
        KP_BEGIN(31)
        for (int it = gw; it < NIT; it += NGW) {
            int r = it;
            if (r < 2 * I_IE) { const int j = r / I_IE; p0_transpose_item(INP(IN_WIE) + (size_t)j * 1024 * 3072, 1024, 3072, WIE + (size_t)j * 3072 * 1024, scr, r % I_IE, lane); continue; } r -= 2 * I_IE;
            if (r < 2 * I_OE) { const int j = r / I_OE; p0_transpose_item(INP(IN_WOE) + (size_t)j * 1024 * 1024, 1024, 1024, WOE + (size_t)j * 1024 * 1024, scr, r % I_OE, lane); continue; } r -= 2 * I_OE;
            if (r < 2 * I_IO) { const int j = r / I_IO; p0_transpose_item(INP(IN_WIO) + (size_t)j * 1024 * 1536, 1024, 1536, WIO + (size_t)j * 1536 * 1024, scr, r % I_IO, lane); continue; } r -= 2 * I_IO;
            if (r < 2 * I_OO) { const int j = r / I_OO; p0_transpose_item(INP(IN_WOO) + (size_t)j * 1024 * 1024, 1024, 1024, WOO + (size_t)j * 1024 * 1024, scr, r % I_OO, lane); continue; } r -= 2 * I_OO;
            { const int j = r / I_WQ; p0_transpose_item(INP(IN_WQ) + (size_t)j * 1024 * 2048, 1024, 2048, WQ + (size_t)j * 2048 * 1024, scr, r % I_WQ, lane); }
        }
        KP_END(31)
        KP_BEGIN(32)
        const size_t gtid = (size_t)vcu * 512 + tid, nthr = (size_t)G * 512;
        cvt_copy(INP(IN_KEYS), KEYS, (size_t)DEPTH * 8 * 2 * 128 * 128 / 8, gtid, nthr);
        cvt_fp4(INP(IN_U), INP(IN_V), (unsigned char*)UB, (size_t)DEPTH * NEXP * DM / 16, peer::U4_SCALE, peer::V4_SCALE, gtid, nthr);
        for (size_t i = gtid; i < 320 * 16; i += nthr) {
            const int pos = (int)(i >> 4), jf = (int)(i & 15); const int pp = pos < 256 ? pos : pos - 256;
            const float inv = powf(10000.f, -(float)jf / 16.f), ang = (float)pp * inv;
            ROPE[i * 2] = cosf(ang); ROPE[i * 2 + 1] = sinf(ang);
        }
        if (gtid < 2) {
            const float* lp = INP(IN_DLAM) + gtid * 256; float s1 = 0.f, s2 = 0.f;
            for (int k = 0; k < 64; ++k) { s1 += lp[k] * lp[64 + k]; s2 += lp[128 + k] * lp[192 + k]; }
            LAM[gtid] = expf(s1) - expf(s2) + (0.8f - 0.6f * expf(-0.3f * (float)(2 * gtid)));
        }
        KP_END(32)
        KP_BEGIN(33)
        __syncthreads();
        LAS float* sv = (LAS float*)F.lds; LAS float* red = (LAS float*)(F.lds + 12288);
        for (int i = tid; i < 3072; i += 512) { const int r = i >> 10, k = i & 1023; sv[i] = silu_f(r < 2 ? INP(IN_C)[r * 1024 + k] : INP(IN_CCTX)[k]); }
        __syncthreads();
        for (int it = vcu; it < DEPTH * 96; it += G) {
            const int L = it / 96, n0 = (it % 96) * 64;
            const float* wm = INP(IN_WMOD) + (size_t)L * 1024 * 6144 + n0 + lane;
            float a0 = 0.f, a1 = 0.f, a2 = 0.f;
#pragma unroll 8
            for (int k = wave * 128; k < wave * 128 + 128; ++k) { const float wv = wm[(size_t)k * 6144]; a0 += sv[k] * wv; a1 += sv[1024 + k] * wv; a2 += sv[2048 + k] * wv; }
            red[(wave * 3 + 0) * 64 + lane] = a0; red[(wave * 3 + 1) * 64 + lane] = a1; red[(wave * 3 + 2) * 64 + lane] = a2;
            __syncthreads();
            if (tid < 192) { const int r = tid >> 6, l = tid & 63; float s = 0.f;
#pragma unroll
                for (int w8 = 0; w8 < 8; ++w8) s += red[(w8 * 3 + r) * 64 + l];
                MOD[((size_t)L * 3 + r) * 6144 + n0 + l] = s + INP(IN_BMOD)[L * 6144 + n0 + l]; }
            __syncthreads();
        }
        KP_END(33)
    }
    KP_END(18) }
    { KP_BEGIN(28)
    SEAM(0);
    KP_END(28) }

    for (int L = 0; L < DEPTH; ++L) {
        unsigned long long kp_L = 0; if (MK_PROBE == 60 + L && KPROBE_ON) kp_L = __builtin_readcyclecounter();
        const int pb = 1 + 8 * L;
        const bool odd = (L & 1) != 0, last = (L == DEPTH - 1); const int j = L >> 1;
#define modL (MOD + (size_t)L * 3 * 6144)
#define xl ((L == 0) ? INP(IN_X) : (const float*)X)
#define xc ((L == 0) ? INP(IN_CTX) : (const float*)(X + (size_t)TL * DM))
        const int MR = last ? TL : TA;
        { KP_BEGIN(10)
        if (KIND_EN(0) && L == 0 && IN(pb)) { WSL;
            for (int row = gw; row < TA; row += NGW) {
                const bool lat = row < TL; const float* xr = lat ? xl + (size_t)row * DM : xc + (size_t)(row - TL) * DM;
                const float* mr = modL + (size_t)(lat ? (row >> 14) : 2) * 6144;
                norm_row<0>(xr, INP(IN_N1G) + L * DM, mr + 1024, mr, H + (size_t)row * DM, nullptr, lane);
            }
        }
        KP_END(10) }
        { KP_BEGIN(20)
        if (L == 0) SEAM(pb);
        KP_END(20) }
        { KP_BEGIN(11)
        if (KIND_EN(1) && IN(pb + 1)) { WSL;
            const int N = odd ? ODD_IN : EVEN_IN;
            if (MK_SKIP) { const size_t gtid = (size_t)vcu * 512 + threadIdx.x, nthr = (size_t)G * 512;
                for (size_t i = gtid; i < (size_t)TA * DM / 8; i += nthr) ((v4u*)O)[i] = (v4u){0u, 0u, 0u, 0u}; }
            pg8::Gemm g{H, odd ? WIO + (size_t)j * ODD_IN * DM : WIE + (size_t)j * EVEN_IN * DM, TA, N, DM}; pg8::StaticOrder S; S.init(TA, N, G, (int)blockIdx.x);
            pg8::EpiProj E{P, N, odd ? 1 : 0, ROPE, C2};
            for (int rep = 0; rep < ((MK_REPEAT & 2) ? 2 : 1); ++rep)
            pg8::gemm_phase<pg8::EpiProj, pg8::StaticOrder, true, true>(F.lds + RING_OFF, g, S, E);
        }
        KP_END(11) }
        { KP_BEGIN(21)
        SEAM(pb + 1);
        KP_END(21) }
        { KP_BEGIN(12)
        if (KIND_EN(2) && IN(pb + 2)) { WSL;
            if (!odd) {
                const float lam = LAM[j], osc = 1.f - (0.8f - 0.6f * expf(-0.3f * (float)L));
                const float* subg = INP(IN_SUBG) + j * 128; const float* rpb = INP(IN_RPB) + (size_t)j * 8 * 465;
                { KP_BEGIN(41)
                for (int rep = 0; rep < ((MK_REPEAT & 4) ? 2 : 1); ++rep)
                if (!(MK_SKIP & 1)) for (int u = vcu; u < 1024; u += G) { const int pair = (u & 255) >> 5, qb = (u & 31) + 32 * (u >> 8); att::diff_unit(false, pair >> 2, pair & 3, qb, P, O, lam, osc, subg, F.lds, probe_acc); }
                KP_END(41) }
                { KP_BEGIN(42)
                for (int rep = 0; rep < ((MK_REPEAT & 1024) ? 2 : 1); ++rep)
                if (!(MK_SKIP & 2)) for (int u = vcu; u < 1024; u += G) { const int pair = (u & 255) >> 4, g4 = (u & 15) + 16 * (u >> 8); att::na_unit(false, pair >> 3, pair & 7, g4, P, O, rpb, F.lds); }
                KP_END(42) }
                if (!last) for (int u = vcu; u < 256; u += G) if ((u & 7) == 0) { const int k = u >> 3;
                    if (k < 16) { if (!(MK_SKIP & 1)) att::diff_unit(true, k >> 3, (k >> 1) & 3, k & 1, P, O, lam, osc, subg, F.lds, probe_acc); }
                    else { if (!(MK_SKIP & 2)) att::na_unit(true, (k - 16) >> 3, (k - 16) & 7, 0, P, O, rpb, F.lds); } }
            } else {
                const float* sink = INP(IN_SINK) + j * 16;
                if (!(MK_SKIP & 4)) {
                { KP_BEGIN(43)
                for (int rep = 0; rep < ((MK_REPEAT & 2048) ? 2 : 1); ++rep)
                for (int u = vcu; u < 2048; u += G) { const int pair = (u & 255) >> 5, qb = (u & 31) + 32 * (u >> 8); att::swa_unit(false, pair >> 2, pair & 3, qb, P, O, sink, F.lds); }
                KP_END(43) }
                if (!last) for (int u = vcu; u < 256; u += G) if ((u & 7) == 0) { const int k = u >> 3; att::swa_unit(true, k >> 4, (k >> 2) & 3, k & 3, P, O, sink, F.lds); }
                }
            }
        }
        KP_END(12) }
        { KP_BEGIN(22)
        SEAM(pb + 2);
        KP_END(22) }
        { KP_BEGIN(13)
        if (KIND_EN(3) && IN(pb + 3)) { WSL;
            pg8::Gemm g{O, odd ? WOO + (size_t)j * DM * DM : WOE + (size_t)j * DM * DM, MR, DM, DM}; pg8::StaticOrder S; S.init(MR, DM, G, (int)blockIdx.x);
            pg8::EpiResid E{xl, xc, X, modL + 2048};
            pg8::gemm_phase<pg8::EpiResid, pg8::StaticOrder, true, true>(F.lds + RING_OFF, g, S, E);
        }
        KP_END(13) }
        { KP_BEGIN(23)
        SEAM(pb + 3);
        KP_END(23) }
        { KP_BEGIN(14)
        if (KIND_EN(4) && IN(pb + 4)) { WSL;
            for (int row = gw; row < MR; row += 2 * NGW) {
                const int rowb = row + NGW;
                const float* ma = modL + (size_t)(row < TL ? (row >> 14) : 2) * 6144;
                if (rowb < MR) { const float* mb = modL + (size_t)(rowb < TL ? (rowb >> 14) : 2) * 6144;
                    norm_row_x2(X + (size_t)row * DM, X + (size_t)rowb * DM, INP(IN_N2G) + L * DM, ma + 4096, ma + 3072, mb + 4096, mb + 3072, H + (size_t)row * DM, H + (size_t)rowb * DM, lane); }
                else norm_row<0>(X + (size_t)row * DM, INP(IN_N2G) + L * DM, ma + 4096, ma + 3072, H + (size_t)row * DM, nullptr, lane);
            }
        }
        KP_END(14) }
        { KP_BEGIN(24)
        SEAM(pb + 4);
        KP_END(24) }
        { KP_BEGIN(15)
        if (KIND_EN(5) && IN(pb + 5)) { WSL;
            pg8::Gemm g{H, WQ + (size_t)L * PQ_N * DM, MR, PQ_N, DM}; pg8::StaticOrder S; S.init(MR, PQ_N, G, (int)blockIdx.x);
            pg8::EpiProj E{PQ, PQ_N, 2, ROPE, 1.f};
            pg8::gemm_phase<pg8::EpiProj, pg8::StaticOrder, true, true>(F.lds + RING_OFF, g, S, E);
        }
        KP_END(15) }
        { KP_BEGIN(25)
        SEAM(pb + 5);
        KP_END(25) }
        { KP_BEGIN(16)
        if (KIND_EN(6) && IN(pb + 6)) { WSL;
            const int nunits = 8 * (MR / 256); int cur_h = -1;
            int tid = threadIdx.x; asm volatile("" : "+v"(tid));
            for (int rep = 0; rep < ((MK_REPEAT & 64) ? 2 : 1); ++rep)
            for (int u = vcu; u < nunits; u += G) {
                int h, cb; if (u < 1024) { h = (u & 255) >> 5; cb = (u & 31) + 32 * (u >> 8); } else { h = (u - 1024) >> 1; cb = 128 + ((u - 1024) & 1); }
                if (h != cur_h) {
                    __syncthreads();
                    const bf16* kg = KEYS + (size_t)(L * 8 + h) * 2 * 128 * 128;
                    for (int c = tid; c < 4096; c += 512) { const int p = c >> 11, row = (c >> 4) & 127, ch = c & 15;
                        *(LAS v4u*)(F.lds + peer::L_KEYS + p * peer::KEYIMG + row * peer::KEYROWB + ch * 16) = *(const v4u*)(kg + (size_t)(p * 128 + row) * 128 + ch * 8); }
                    __syncthreads(); cur_h = h;
                }
                peer::topk_wave(PQ, (size_t)cb * 256 + wave * 32, h, F.lds + peer::L_KEYS, (LAS unsigned*)(F.lds + peer::L_TAB) + wave * 512, IDX, GATE, lane);
            }
        }
        KP_END(16) }
        { KP_BEGIN(26)
        SEAM(pb + 6);
        KP_END(26) }
        { KP_BEGIN(17)
        if (KIND_EN(7) && IN(pb + 7)) { WSL;
            const unsigned char* Ul = (const unsigned char*)UB + (size_t)L * NEXP * DM; const unsigned char* Vl = (const unsigned char*)VB + (size_t)L * NEXP * DM;
#define EXPERT_FINISH(FF, tt) do { const int t = (tt); \
                const float* g2 = modL + (size_t)(t < TL ? (t >> 14) : 2) * 6144 + 5120 + 16 * lane; \
                float* xr = X + (size_t)t * DM + 16 * lane; \
                f32x4 xn[4]; float ss = 0.f; \
                _Pragma("unroll") for (int c = 0; c < 4; ++c) { \
                    f32x4 xa = *(const f32x4*)(xr + 4 * c); const f32x4 ga = *(const f32x4*)(g2 + 4 * c); \
                    xa += ga * (f32x4){FF[2 * c].x, FF[2 * c].y, FF[2 * c + 1].x, FF[2 * c + 1].y}; \
                    if (!last) *(f32x4*)(xr + 4 * c) = xa; \
                    xn[c] = xa; ss += (xa.x * xa.x + xa.y * xa.y) + (xa.z * xa.z + xa.w * xa.w); } \
                const float rstd = __builtin_amdgcn_rsqf(wave_sum(ss) * (1.f / DM) + EPS); \
                if (!last) { \
                    const float* mn = MOD + (size_t)(L + 1) * 3 * 6144 + (size_t)(t < TL ? (t >> 14) : 2) * 6144 + 16 * lane; \
                    const float* gn = INP(IN_N1G) + (L + 1) * DM + 16 * lane; \
                    unsigned ow[8]; \
                    _Pragma("unroll") for (int c = 0; c < 4; ++c) { \
                        const f32x4 y = xn[c] * rstd * *(const f32x4*)(gn + 4 * c) * (*(const f32x4*)(mn + 1024 + 4 * c) + 1.f) + *(const f32x4*)(mn + 4 * c); \
                        ow[2 * c] = pk2(y.x, y.y); ow[2 * c + 1] = pk2(y.z, y.w); } \
                    bf16* hr = H + (size_t)t * DM + 16 * lane; *(v4u*)hr = (v4u){ow[0], ow[1], ow[2], ow[3]}; *(v4u*)(hr + 8) = (v4u){ow[4], ow[5], ow[6], ow[7]}; \
                } else { \
                    const float* fg = INP(IN_FG) + 16 * lane; float* orow = (float*)(GAS float*)KARG(fptr_t, 168) + (size_t)t * DM + 16 * lane; \
                    _Pragma("unroll") for (int c = 0; c < 4; ++c) *(f32x4*)(orow + 4 * c) = xn[c] * rstd * *(const f32x4*)(fg + 4 * c); } \
                __builtin_amdgcn_sched_barrier(0);     \
            } while (0)
            const unsigned char* UV6 = (const unsigned char*)UB + (size_t)L * NEXP * 64 * 16;
            const int lane_p = lane;
            for (int t1 = gw; t1 < MR; t1 += NGW) {
                peer::f2 f[8];
                { int lane = lane_p; asm volatile("" : "+v"(lane));
                  peer::expert_token4(H + (size_t)t1 * DM, IDX + (size_t)t1 * 128, GATE + (size_t)t1 * 128, UV6, f, lane); }
                { int lane = lane_p; asm volatile("" : "+v"(lane)); EXPERT_FINISH(f, t1); }
            }
#undef EXPERT_FINISH
        }
        KP_END(17) }
        { KP_BEGIN(27)
        if (!last) SEAM(pb + 7);
        KP_END(27) }
        if (MK_PROBE == 60 + L && KPROBE_ON) probe_acc += __builtin_readcyclecounter() - kp_L;
    }
    if (MK_PROBE != 0) { KP_BEGIN(29) xcd_barrier(bar); KP_END(29) }
    if (MK_PROBE != 0 && blockIdx.x == 0 && wave == 0) { const unsigned long long t0 = __builtin_readcyclecounter(); while (__builtin_readcyclecounter() - t0 < probe_acc) __builtin_amdgcn_s_sleep(8); }
#undef IN
#undef SEAM
}

extern "C" void kernel_launch(void* const* d_in, const int* in_sizes, int n_in, void* d_out, int out_size, void* d_ws, size_t ws_size, hipStream_t stream) {
    static int grid = 0;
    if (grid == 0) {
        if (n_in != 21 || in_sizes[0] != TL * DM || out_size != TL * DM || ws_size < WS_END) {
            fprintf(stderr, "kernel_launch: unexpected shapes (n_in %d, in0 %d, out %d, ws %zu); nothing launched\n", n_in, n_in > 0 ? in_sizes[0] : -1, out_size, ws_size); grid = -1; return; }
        int dev = 0, cus = 0, per_cu = 0;
        if (hipGetDevice(&dev) != hipSuccess || hipDeviceGetAttribute(&cus, hipDeviceAttributeMultiprocessorCount, dev) != hipSuccess) { fprintf(stderr, "kernel_launch: device query failed\n"); grid = -1; return; }
        if (hipFuncSetAttribute((const void*)fwd, hipFuncAttributeMaxDynamicSharedMemorySize, LDS_BYTES) != hipSuccess) { fprintf(stderr, "kernel_launch: hipFuncSetAttribute failed\n"); grid = -1; return; }
        if (hipOccupancyMaxActiveBlocksPerMultiprocessor(&per_cu, (const void*)fwd, NWAVES * 64, LDS_BYTES) != hipSuccess || per_cu < 1)
            fprintf(stderr, "kernel_launch: note: occupancy query reports %d workgroups per CU\n", per_cu);
        (void)hipGetLastError();
        grid = cus;
    }
    if (grid < 0) return;
    if (hipMemsetAsync((char*)d_ws + WS_CTL, 0, CTL_ZERO_BYTES, stream) != hipSuccess) { fprintf(stderr, "kernel_launch: memset failed\n"); return; }
    Args a{};
    for (int i = 0; i < 21; ++i) a.in[i] = (const float*)d_in[i];
    a.out = (float*)d_out; a.ws = (unsigned char*)d_ws;
#if MK_PER_PHASE
    for (int p = 0; p < NPHASES; ++p) { a.ph_lo = p; a.ph_hi = p + 1; hipLaunchKernelGGL(fwd, dim3(grid), dim3(NWAVES * 64), LDS_BYTES, stream, a); }
#else
    a.ph_lo = 0; a.ph_hi = NPHASES;
    hipLaunchKernelGGL(fwd, dim3(grid), dim3(NWAVES * 64), LDS_BYTES, stream, a);
#endif
    const hipError_t le = hipPeekAtLastError();
    if (le != hipSuccess) fprintf(stderr, "kernel_launch: launch failed: %s\n", hipGetErrorName(le));
}
```

```cpp
#define MK_KINDS 0x3FF
#define MK_SKIP 0
#define MK_PER_PHASE 0
#define MK_REPEAT 0
#define MK_PROBE 0
#include <hip/hip_runtime.h>
#include <hip/hip_bf16.h>
#include <cstdio>
#include <cstdint>
#include <cstddef>
#include <cmath>
namespace pg8 {
#define PG8_LAS __attribute__((address_space(3)))
typedef unsigned short bf16_t;
typedef short bf16x8 __attribute__((ext_vector_type(8)));
typedef float f32x4 __attribute__((ext_vector_type(4)));
typedef unsigned u32x4 __attribute__((ext_vector_type(4)));
constexpr int BM = 256, BK = 64, HALF = 128, HTB = HALF * BK * 2  , STAGE_BYTES = 8 * HTB, NXCD = 8, WGM = 8;

__host__ __device__ __forceinline__ int lds_byte(int r, int c) { const int st = (r >> 4) * 2 + (c >> 5), rr = r & 15, cc = c & 31, ob = rr * 64 + cc * 2; return st * 1024 + (ob ^ (((ob >> 9) & 1) << 5)); }
__host__ __device__ __forceinline__ void stage_rc(int b, int& R, int& C) { const int st = b / 1024, sb = b % 1024, swz = sb ^ (((sb >> 9) & 1) << 5); R = (st >> 1) * 16 + swz / 64; C = (st & 1) * 32 + (swz % 64) / 2; }
__host__ __device__ __forceinline__ int perm32(int rho) { const int n = rho >> 4, i = rho & 15; return 8 * (i >> 2) + 4 * n + (i & 3); }

struct Unit { int pm, pn; };
struct Gemm { const bf16_t* A; const bf16_t* Bt; int M, N, K; };

struct StaticOrder {
    int nM, nN, nwg, G, c;
    __host__ __device__ void init(int M, int N, int G_, int c_) { nM = M / BM; nN = N / BM; nwg = nM * nN; G = G_; c = c_; }
    __host__ __device__ bool next(int i, Unit& u) const {
        const long L = (long)i * G + c; if (L >= nwg) return false;
        int wgid = (int)L; { const int q = nwg / NXCD, r = nwg % NXCD, xcd = wgid % NXCD, off = wgid / NXCD; wgid = (xcd < r ? xcd * (q + 1) : r * (q + 1) + (xcd - r) * q) + off; }
        const int nig = WGM * nN, gid = wgid / nig, fm = gid * WGM, gsz = (nM - fm) < WGM ? (nM - fm) : WGM;
        u.pm = fm + ((wgid % nig) % gsz); u.pn = (wgid % nig) / gsz; return true;
    }
    __device__ __forceinline__ void a_ready(const Unit&) const {}
    __device__ __forceinline__ void done(const Unit&) const {}
};

__device__ __forceinline__ unsigned cvt_pk_bf16(float lo, float hi) { unsigned r; asm volatile("v_cvt_pk_bf16_f32 %0, %1, %2" : "=v"(r) : "v"(lo), "v"(hi)); return r; }
typedef float f32x2 __attribute__((ext_vector_type(2)));
struct EpiProj {
    static constexpr bool PERM = true, AFTER_DRAIN = false;
    bf16_t* O; int ldc; int mode; const float* rope; float qscale;
    __device__ __forceinline__ void operator()(const f32x4 (&acc)[2][2][4][2], const Unit& u, int wr, int wc, int fr, int fq) const {
        const int pn = u.pn;
        bool isq = false, isrope = false;
        if (mode == 0) { isq = (pn < 2) || (pn == 6) || (pn == 7); isrope = (pn >= 6) && (pn <= 9); }
        else if (mode == 1) { isq = pn < 4; isrope = pn < 5; }
        isrope = isrope && (u.pm < 128);
        const float sc = isq ? qscale : 1.f;
        const int row0 = u.pm * BM + wr * 64 + fr, col0 = u.pn * BM + wc * 32 + 8 * fq;
        const float sgn = (fq & 2) ? 1.f : -1.f;
#pragma unroll
        for (int ai = 0; ai < 2; ++ai)
#pragma unroll
            for (int m = 0; m < 4; ++m) {
                const int row = row0 + ai * HALF + m * 16;
                bf16_t* rowp = O + (size_t)row * ldc + col0;
                f32x4 cs[4];
                if (isrope) {
                    const int t = row & 16383; const int pos = (wc & 1) ? 256 + (t & 63) : (t >> 6);
                    const f32x4* rp = (const f32x4*)(rope + (size_t)(pos * 16 + 8 * (fq & 1)) * 2);
                    cs[0] = rp[0]; cs[1] = rp[1]; cs[2] = rp[2]; cs[3] = rp[3];
                }
#pragma unroll
                for (int bj = 0; bj < 2; ++bj) {
                    f32x4 v0 = acc[ai][bj][m][0], v1 = acc[ai][bj][m][1];
                    if (isrope) {
                        float x[8] = {v0[0], v0[1], v0[2], v0[3], v1[0], v1[1], v1[2], v1[3]};
#pragma unroll
                        for (int j = 0; j < 8; ++j) {
                            const float pr = __shfl_xor(x[j], 32);
                            const float c = cs[j >> 1][(j & 1) * 2], s = cs[j >> 1][(j & 1) * 2 + 1];
                            x[j] = x[j] * c + sgn * pr * s;
                        }
                        v0 = (f32x4){x[0], x[1], x[2], x[3]}; v1 = (f32x4){x[4], x[5], x[6], x[7]};
                    }
                    v0 = v0 * sc; v1 = v1 * sc;
                    u32x4 w; w.x = cvt_pk_bf16(v0[0], v0[1]); w.y = cvt_pk_bf16(v0[2], v0[3]); w.z = cvt_pk_bf16(v1[0], v1[1]); w.w = cvt_pk_bf16(v1[2], v1[3]);
                    *(u32x4*)(rowp + bj * HALF) = w;
                }
            }
    }
};
struct EpiResid {
    static constexpr bool PERM = false, AFTER_DRAIN = false;
    const float* base32_lat; const float* base32_ctx; const bf16_t* base16; bf16_t* out; const float* gate;
    __device__ __forceinline__ void operator()(const f32x4 (&acc)[2][2][4][2], const Unit& u, int wr, int wc, int fr, int fq) const {
        typedef unsigned u32x2 __attribute__((ext_vector_type(2)));
        const int row0 = u.pm * BM + wr * 64 + fr, col0 = u.pn * BM + wc * 32 + 4 * fq;
        const bool lat = u.pm < 128;
        const int mrow = lat ? (u.pm >> 6) : 2;
        const float* gp = gate + (size_t)mrow * 6144 + col0;
        f32x4 gv[2][2];
#pragma unroll
        for (int bj = 0; bj < 2; ++bj)
#pragma unroll
            for (int n = 0; n < 2; ++n) gv[bj][n] = *(const f32x4*)(gp + bj * HALF + n * 16);
#pragma unroll
        for (int ai = 0; ai < 2; ++ai)
#pragma unroll
            for (int m = 0; m < 4; ++m) {
                const int row = row0 + ai * HALF + m * 16;
                const float* bp32 = base32_lat ? (lat ? base32_lat + (size_t)row * 1024 + col0 : base32_ctx + (size_t)(row - 32768) * 1024 + col0) : nullptr;
                const bf16_t* bp16 = base16 + (size_t)row * 1024 + col0;
                bf16_t* op = out + (size_t)row * 1024 + col0;
#pragma unroll
                for (int bj = 0; bj < 2; ++bj)
#pragma unroll
                    for (int n = 0; n < 2; ++n) {
                        f32x4 b;
                        if (base32_lat) b = *(const f32x4*)(bp32 + bj * HALF + n * 16);
                        else { const u32x2 w = *(const u32x2*)(bp16 + bj * HALF + n * 16);
                            b = (f32x4){__uint_as_float(w.x << 16), __uint_as_float(w.x & 0xffff0000u), __uint_as_float(w.y << 16), __uint_as_float(w.y & 0xffff0000u)}; }
                        const f32x4 o = b + gv[bj][n] * acc[ai][bj][m][n];
                        u32x2 ow; ow.x = cvt_pk_bf16(o[0], o[1]); ow.y = cvt_pk_bf16(o[2], o[3]);
                        *(u32x2*)(op + bj * HALF + n * 16) = ow;
                    }
            }
    }
};
template <class Epi, class Sched, bool ALIGN_EPI = false, bool SP2 = false>
__device__ __forceinline__ void gemm_phase(PG8_LAS unsigned char* lds, const Gemm g, const Sched& S, const Epi& E) {
    int tid = threadIdx.x; asm volatile("" : "+v"(tid));
    const int wid = __builtin_amdgcn_readfirstlane(tid >> 6), lane = tid & 63, wr = wid >> 2, wc = wid & 3, fr = lane & 15, fq = lane >> 4;
    const int K = g.K, nt = K / BK;
    unsigned voffA[2], voffB[2];
#pragma unroll
    for (int i = 0; i < 2; ++i) { int R, C; stage_rc(tid * 16 + i * 8192, R, C); const int Rb = Epi::PERM ? ((R & ~31) + perm32(R & 31)) : R;
        voffA[i] = (unsigned)(R * K + C) * 2u; voffB[i] = (unsigned)(Rb * K + C) * 2u; }
    const size_t kstep = (size_t)(BK * 2);
    const size_t hstep = (size_t)HALF * K * 2;
    const size_t tstep = 2 * hstep;
    const unsigned ldsw = (unsigned)wid * 1024u;
    const int aoff = lds_byte(wr * 64 + fr, fq * 8), boff = lds_byte(wc * 32 + fr, fq * 8);
#define PG8_SA(b, h) (((b) * 2 + (h)) * HTB)
#define PG8_SB(b, h) ((4 + (b) * 2 + (h)) * HTB)
#define PG8_STAGE(bufoff, gbase, voff) do { _Pragma("unroll") for (int _i = 0; _i < 2; ++_i) \
        __builtin_amdgcn_global_load_lds((const unsigned*)((const char*)(gbase) + (voff)[_i]), (PG8_LAS unsigned*)(lds + (bufoff) + ldsw + _i * 8192), 16, 0, 0); } while (0)
#define PG8_LDA(dst, b, h) do { _Pragma("unroll") for (int m = 0; m < 4; ++m) _Pragma("unroll") for (int k = 0; k < 2; ++k) dst[m][k] = *(const PG8_LAS bf16x8*)(lds + PG8_SA(b, h) + aoff + m * 2048 + k * 1024); } while (0)
#define PG8_LDB(dst, b, h) do { _Pragma("unroll") for (int n = 0; n < 2; ++n) _Pragma("unroll") for (int k = 0; k < 2; ++k) dst[n][k] = *(const PG8_LAS bf16x8*)(lds + PG8_SB(b, h) + boff + n * 2048 + k * 1024); } while (0)
#define PG8_MMA(ai, bj, At, Bt) do { __builtin_amdgcn_s_setprio(1); _Pragma("unroll") for (int m = 0; m < 4; ++m) _Pragma("unroll") for (int n = 0; n < 2; ++n) _Pragma("unroll") for (int k = 0; k < 2; ++k) \
        acc[ai][bj][m][n] = __builtin_amdgcn_mfma_f32_16x16x32_bf16(Bt[n][k], At[m][k], acc[ai][bj][m][n], 0, 0, 0); __builtin_amdgcn_s_setprio(0); } while (0)
#define PG8_WAIT_V(n) asm volatile("s_waitcnt vmcnt(" #n ")" ::: "memory")
#define PG8_WAIT_L(n) asm volatile("s_waitcnt lgkmcnt(" #n ")" ::: "memory")
#define PG8_BAR __builtin_amdgcn_s_barrier()
#define PG8_SCHED __builtin_amdgcn_sched_barrier(0)
    Unit cur, nxt; int ui = 0;
    if (!S.next(0, cur)) return;
    f32x4 acc[2][2][4][2];
#pragma unroll
    for (int a = 0; a < 2; ++a)
#pragma unroll
        for (int b = 0; b < 2; ++b)
#pragma unroll
            for (int m = 0; m < 4; ++m)
#pragma unroll
                for (int n = 0; n < 2; ++n) acc[a][b][m][n] = (f32x4){0.f, 0.f, 0.f, 0.f};
    bf16x8 At[4][2], B0[2][2], B1[2][2];
    const char* cA = (const char*)g.A + (size_t)cur.pm * tstep; const char* cB = (const char*)g.Bt + (size_t)cur.pn * tstep;
    S.a_ready(cur);
    if constexpr (SP2) {
        PG8_STAGE(PG8_SB(0, 0), cB, voffB); PG8_STAGE(PG8_SB(0, 1), cB + hstep, voffB); PG8_STAGE(PG8_SA(0, 0), cA, voffA); PG8_STAGE(PG8_SA(0, 1), cA + hstep, voffA);
        if (wr == 1) PG8_BAR;
        PG8_WAIT_V(2); PG8_BAR;
        PG8_STAGE(PG8_SB(1, 0), cB + kstep, voffB); PG8_STAGE(PG8_SA(1, 0), cA + kstep, voffA); PG8_STAGE(PG8_SB(1, 1), cB + hstep + kstep, voffB);
        PG8_WAIT_V(6); PG8_BAR;
    } else {
        PG8_STAGE(PG8_SB(0, 0), cB, voffB); PG8_STAGE(PG8_SA(0, 0), cA, voffA); PG8_STAGE(PG8_SB(0, 1), cB + hstep, voffB); PG8_STAGE(PG8_SA(0, 1), cA + hstep, voffA);
        if (wr == 1) PG8_BAR;
        PG8_WAIT_V(4); PG8_BAR;
        PG8_STAGE(PG8_SB(1, 0), cB + kstep, voffB); PG8_STAGE(PG8_SA(1, 0), cA + kstep, voffA); PG8_STAGE(PG8_SB(1, 1), cB + hstep + kstep, voffB);
        PG8_WAIT_V(6); PG8_BAR;
    }
    for (;;) {
        const bool has_next = S.next(ui + 1, nxt);
        const char* nA = has_next ? (const char*)g.A + (size_t)nxt.pm * tstep : cA; const char* nB = has_next ? (const char*)g.Bt + (size_t)nxt.pn * tstep : cB;
        for (int t = 0; t < nt; t += 2) {
            const bool last = (t == nt - 2);
            const char* a1 = cA + (size_t)(t + 1) * kstep;
            const char* a2 = last ? nA : cA + (size_t)(t + 2) * kstep; const char* b2 = last ? nB : cB + (size_t)(t + 2) * kstep;
            const char* a3 = a2 + kstep; const char* b3 = b2 + kstep;
            if (last && has_next) S.a_ready(nxt);
            if constexpr (SP2) {
            PG8_LDB(B0, 0, 0); PG8_LDB(B1, 0, 1); PG8_SCHED; PG8_LDA(At, 0, 0); PG8_STAGE(PG8_SA(1, 1), a1 + hstep, voffA);
            PG8_WAIT_V(8); PG8_WAIT_L(0); PG8_BAR; PG8_MMA(0, 0, At, B0); PG8_MMA(0, 1, At, B1); PG8_BAR; PG8_SCHED;
            PG8_LDA(At, 0, 1); PG8_STAGE(PG8_SB(0, 0), b2, voffB); PG8_STAGE(PG8_SB(0, 1), b2 + hstep, voffB); PG8_STAGE(PG8_SA(0, 0), a2, voffA);
            PG8_WAIT_V(8); PG8_WAIT_L(0); PG8_BAR; PG8_MMA(1, 0, At, B0); PG8_MMA(1, 1, At, B1); PG8_BAR; PG8_SCHED;
            PG8_LDB(B0, 1, 0); PG8_LDB(B1, 1, 1); PG8_SCHED; PG8_LDA(At, 1, 0); PG8_STAGE(PG8_SA(0, 1), a2 + hstep, voffA);
            PG8_WAIT_V(8); PG8_WAIT_L(0); PG8_BAR; PG8_MMA(0, 0, At, B0); PG8_MMA(0, 1, At, B1); PG8_BAR; PG8_SCHED;
            PG8_LDA(At, 1, 1); PG8_STAGE(PG8_SB(1, 0), b3, voffB); PG8_STAGE(PG8_SB(1, 1), b3 + hstep, voffB); PG8_STAGE(PG8_SA(1, 0), a3, voffA);
            PG8_WAIT_V(8); PG8_WAIT_L(0); PG8_BAR; PG8_MMA(1, 0, At, B0); PG8_MMA(1, 1, At, B1); PG8_BAR; PG8_SCHED;
            } else {
            PG8_LDB(B0, 0, 0); PG8_SCHED; PG8_LDA(At, 0, 0); PG8_STAGE(PG8_SA(1, 1), a1 + hstep, voffA);
            PG8_WAIT_L(8); PG8_BAR; PG8_WAIT_L(0); PG8_MMA(0, 0, At, B0); PG8_BAR; PG8_SCHED;
            PG8_LDB(B1, 0, 1); PG8_STAGE(PG8_SB(0, 0), b2, voffB);
            PG8_BAR; PG8_WAIT_L(0); PG8_MMA(0, 1, At, B1); PG8_BAR;
            PG8_LDA(At, 0, 1); PG8_STAGE(PG8_SA(0, 0), a2, voffA);
            PG8_BAR; PG8_WAIT_L(0); PG8_MMA(1, 0, At, B0); PG8_BAR; PG8_SCHED;
            PG8_STAGE(PG8_SB(0, 1), b2 + hstep, voffB);
            PG8_WAIT_V(6); PG8_BAR; PG8_MMA(1, 1, At, B1); PG8_BAR;
            PG8_LDB(B0, 1, 0); PG8_SCHED; PG8_LDA(At, 1, 0); PG8_STAGE(PG8_SA(0, 1), a2 + hstep, voffA);
            PG8_WAIT_L(8); PG8_BAR; PG8_WAIT_L(0); PG8_MMA(0, 0, At, B0); PG8_BAR; PG8_SCHED;
            PG8_LDB(B1, 1, 1); PG8_STAGE(PG8_SB(1, 0), b3, voffB);
            PG8_BAR; PG8_WAIT_L(0); PG8_MMA(0, 1, At, B1); PG8_BAR;
            PG8_LDA(At, 1, 1); PG8_STAGE(PG8_SA(1, 0), a3, voffA);
            PG8_BAR; PG8_WAIT_L(0); PG8_MMA(1, 0, At, B0); PG8_BAR; PG8_SCHED;
            PG8_STAGE(PG8_SB(1, 1), b3 + hstep, voffB);
            PG8_WAIT_V(6); PG8_BAR; PG8_MMA(1, 1, At, B1); PG8_BAR;
            }
        }
        if constexpr (ALIGN_EPI) { if (wr == 0) PG8_BAR; }
        if constexpr (!Epi::AFTER_DRAIN) { E(acc, cur, wr, wc, fr, fq); S.done(cur); }
        if (!has_next) break;
#pragma unroll
        for (int a = 0; a < 2; ++a)
#pragma unroll
            for (int b = 0; b < 2; ++b)
#pragma unroll
                for (int m = 0; m < 4; ++m)
#pragma unroll
                    for (int n = 0; n < 2; ++n) acc[a][b][m][n] = (f32x4){0.f, 0.f, 0.f, 0.f};
        cur = nxt; cA = nA; cB = nB; ++ui;
        if constexpr (ALIGN_EPI) { if (wr == 1) PG8_BAR; }
    }
    PG8_WAIT_V(0);
    if constexpr (!ALIGN_EPI) { if (wr == 0) PG8_BAR; }
    PG8_BAR;
    if constexpr (Epi::AFTER_DRAIN) { E.fused(acc, cur, wr, wc, fr, fq, lds, wid, lane); S.done(cur); }
#undef PG8_SA
#undef PG8_SB
#undef PG8_STAGE
#undef PG8_LDA
#undef PG8_LDB
#undef PG8_MMA
#undef PG8_WAIT_V
#undef PG8_WAIT_L
#undef PG8_BAR
#undef PG8_SCHED
}
}
#define GAS __attribute__((address_space(1)))
#define LAS __attribute__((address_space(3)))
typedef unsigned short bf16;
typedef unsigned v4u __attribute__((ext_vector_type(4)));
typedef float f32x4 __attribute__((ext_vector_type(4)));
typedef short bf16x8 __attribute__((ext_vector_type(8)));
typedef GAS unsigned gu32;
typedef GAS unsigned long long gu64;
#define RLX_AGENT __ATOMIC_RELAXED, __HIP_MEMORY_SCOPE_AGENT
#define LDS_WAIT() asm volatile("s_waitcnt lgkmcnt(0)" ::: "memory")
#define VM_WAIT() asm volatile("s_waitcnt vmcnt(0)" ::: "memory")
__device__ __forceinline__ unsigned long long rt() { return __builtin_amdgcn_s_memrealtime(); }
__device__ __forceinline__ unsigned f2bf(float f) { unsigned u = __builtin_bit_cast(unsigned, f); return (u + 0x7fffu + ((u >> 16) & 1u)) >> 16; }
__device__ __forceinline__ unsigned pk2(float lo, float hi) { return f2bf(lo) | (f2bf(hi) << 16); }
#define XB_TMO      128
#define XB_XCNT(j)  (256  + 64 * (j))
#define XB_XSUB(j)  (1280 + 64 * (j))
#define XB_XGEN(j)  (2304 + 64 * (j))
#define XB_TOP      3328
#define XB_TOPGEN   3392
#define XCD_BAR_WORDS 3456
#define XB_SPIN_CAP (1u << 18)

__device__ __forceinline__ unsigned xb_ld(unsigned* p)              { return __hip_atomic_load(p, __ATOMIC_RELAXED, __HIP_MEMORY_SCOPE_AGENT); }
__device__ __forceinline__ unsigned xb_add(unsigned* p, unsigned v) { return __hip_atomic_fetch_add(p, v, __ATOMIC_RELAXED, __HIP_MEMORY_SCOPE_AGENT); }
__device__ __forceinline__ unsigned xb_xcc_id() { return (unsigned)__builtin_amdgcn_s_getreg((3 << 11) | 20) & 0xFu; }
#define XB_SPIN(cond, bar) do { unsigned _sp = 0; while (cond) { __builtin_amdgcn_s_sleep(1); \
    if ((++_sp & 255u) == 0u) { if (xb_ld(&(bar)[XB_TMO])) break; if (_sp > XB_SPIN_CAP) { atomicAdd(&(bar)[XB_TMO], 1u); break; } } } } while (0)

struct XcdBarrier {
    unsigned* bar; unsigned x;
    volatile LAS unsigned* st;
};

__device__ __forceinline__ XcdBarrier xcd_barrier_post(unsigned* bar, volatile LAS unsigned* st) {
    XcdBarrier b; b.bar = bar; b.x = xb_xcc_id(); b.st = st;
    if (threadIdx.x == 0) (void)xb_add(&bar[XB_XCNT(b.x)], 1u);
    return b;
}
__device__ __forceinline__ void xcd_barrier_complete(unsigned* bar, unsigned x, unsigned& nloc, unsigned& nx) {
    const unsigned G = gridDim.x * gridDim.y * gridDim.z;
    unsigned sum, cnt, mine, sp = 0u;
    for (;;) {
        sum = 0u; cnt = 0u; mine = 0u;
#pragma unroll
        for (unsigned j = 0; j < 16; ++j) { const unsigned c = xb_ld(&bar[XB_XCNT(j)]); sum += c; cnt += (c > 0u) ? 1u : 0u; mine = (j == x) ? c : mine; }
        if (sum == G) break;
        __builtin_amdgcn_s_sleep(1);
        if ((++sp & 255u) == 0u) { if (xb_ld(&bar[XB_TMO])) break; if (sp > XB_SPIN_CAP) { atomicAdd(&bar[XB_TMO], 1u); break; } }
    }
    nloc = mine > 0u ? mine : 1u; nx = cnt > 0u ? cnt : 1u;
}

__device__ __forceinline__ void xcd_barrier(const XcdBarrier& b) {
    asm volatile("s_waitcnt vmcnt(0)" ::: "memory");
    __syncthreads();
    if (threadIdx.x == 0) {
        unsigned* bar = b.bar;
        __builtin_amdgcn_s_waitcnt(0);
        unsigned nloc = b.st[0], nx = b.st[1];
        if (nloc == 0u) { xcd_barrier_complete(bar, b.x, nloc, nx); b.st[0] = nloc; b.st[1] = nx; }
        const unsigned old = xb_add(&bar[XB_XSUB(b.x)], 1u);
        const unsigned gen = old / nloc;
        if (old + 1u == (gen + 1u) * nloc) {
            __builtin_amdgcn_fence(__ATOMIC_RELEASE, "agent");
            asm volatile("s_waitcnt vmcnt(0)" ::: "memory");
            const unsigned og = xb_add(&bar[XB_TOP], 1u);
            const unsigned tg = og / nx;
            if (og + 1u == (tg + 1u) * nx) xb_add(&bar[XB_TOPGEN], 1u);
            else XB_SPIN(xb_ld(&bar[XB_TOPGEN]) == tg, bar);
            __builtin_amdgcn_fence(__ATOMIC_ACQUIRE, "agent");
            xb_add(&bar[XB_XGEN(b.x)], 1u);
            asm volatile("s_waitcnt vmcnt(0)" ::: "memory");
        } else {
            XB_SPIN(xb_ld(&bar[XB_XGEN(b.x)]) == gen, bar);
            __builtin_amdgcn_fence(__ATOMIC_ACQUIRE, "agent");
            asm volatile("s_waitcnt vmcnt(0)" ::: "memory");
        }
    }
    __syncthreads();
}

__device__ __forceinline__ float wave_sum(float v) {
#pragma unroll
    for (int o = 1; o < 64; o <<= 1) v += __shfl_xor(v, o);
    return v;
}
constexpr int NWAVES = 8;
constexpr int BATCH = 2, SEQ = 16384, DM = 1024, CTXL = 256, DEPTH = 4;
constexpr int TL = BATCH * SEQ;
constexpr int TC = BATCH * CTXL;
constexpr int TA = TL + TC;
constexpr int EVEN_IN = 3072, ODD_IN = 1536, PQ_N = 2048, NEXP = 16384;
constexpr float EPS = 1e-6f;
constexpr float LOG2E = 1.4426950408889634f;
constexpr float C2 = 0.125f * LOG2E;

constexpr size_t MiB = 1u << 20;
constexpr size_t WS_CTL = 0, CTL_ZERO_BYTES = 1 * MiB;
constexpr size_t WS_MOD = 1 * MiB;
constexpr size_t WS_ROPE = WS_MOD + 512 * 1024;
constexpr size_t WS_LAM = WS_ROPE + 64 * 1024;
constexpr size_t WS_WIE = 2 * MiB;
constexpr size_t WS_WOE = 14 * MiB;
constexpr size_t WS_WIO = 18 * MiB;
constexpr size_t WS_WOO = 24 * MiB;
constexpr size_t WS_WQ = 28 * MiB;
constexpr size_t WS_KEYS = 44 * MiB;
constexpr size_t WS_U = 48 * MiB;
constexpr size_t WS_V = 176 * MiB;
constexpr size_t WS_X = 304 * MiB;
constexpr size_t WS_H = 434 * MiB;
constexpr size_t WS_P = 499 * MiB;
constexpr size_t WS_O = 694 * MiB;
constexpr size_t WS_IDX = 759 * MiB;
constexpr size_t WS_GATE = 776 * MiB;
constexpr size_t WS_END = 793 * MiB;
constexpr int CW_BAR = 4096;

constexpr int RING_OFF = 0, RING_BYTES = 131072;
constexpr int LDSCTL_OFF = 162816, MISC_OFF = LDSCTL_OFF + 320;
constexpr int LDS_BYTES = 163840;

namespace att {
#ifndef MK_PROBE
#define MK_PROBE 0
#endif
#define PROBE_BEGIN(id) unsigned long long pb_##id = 0; if (MK_PROBE == (id) && probe_on) pb_##id = __builtin_readcyclecounter();
#define PROBE_END(id) if (MK_PROBE == (id) && probe_on) probe_acc += __builtin_readcyclecounter() - pb_##id;
typedef short bf16x8 __attribute__((ext_vector_type(8)));
typedef short s16x4 __attribute__((ext_vector_type(4)));
typedef float f32x16 __attribute__((ext_vector_type(16)));
typedef unsigned u32x4 __attribute__((ext_vector_type(4)));
typedef LAS unsigned char* lptr;
constexpr int KROWB = 144, KIMG = 64 * KROWB;
constexpr int ST_BYTES = 2 * KIMG + 64 * 128 * 2;
constexpr int L_WSF = 3 * ST_BYTES, L_RPB = L_WSF + NWAVES * 256, L_Q = L_RPB + 2048, L_END = L_Q + NWAVES * 4096;
static_assert(L_END <= LDSCTL_OFF, "attention LDS");
constexpr float THR = 4.f;
constexpr int PLD = EVEN_IN;

__device__ __forceinline__ int crow(int r, int hi) { return (r & 3) + 8 * (r >> 2) + 4 * hi; }
__device__ __forceinline__ unsigned cvtpk(float lo, float hi) { typedef float f2 __attribute__((ext_vector_type(2))); typedef __bf16 b2 __attribute__((ext_vector_type(2)));
    f2 v = {lo, hi}; b2 b = __builtin_convertvector(v, b2); return __builtin_bit_cast(unsigned, b); }
__device__ __forceinline__ float partner32(float v, int hi) {
    auto rr = __builtin_amdgcn_permlane32_swap(__float_as_uint(v), __float_as_uint(v), false, false);
    return __uint_as_float(hi ? rr[0] : rr[1]);
}
typedef short v4i16_t __attribute__((ext_vector_type(4)));
__device__ __forceinline__ s16x4 vtr(lptr p) { return __builtin_bit_cast(s16x4, __builtin_amdgcn_ds_read_tr16_b64_v4i16((LAS v4i16_t*)p)); }

__device__ __forceinline__ float max3f(float a, float b, float c) { float r; asm("v_max3_f32 %0, %1, %2, %3" : "=v"(r) : "v"(a), "v"(b), "v"(c)); return r; }
__device__ __forceinline__ float max2f(float a, float b) { float r; asm("v_max_f32_e32 %0, %1, %2" : "=v"(r) : "v"(a), "v"(b)); return r; }
__device__ __forceinline__ float rowmax32(f32x16& p0, f32x16& p1, int hi) {
    asm volatile("s_nop 15\n\ts_nop 7" : "+v"(p0), "+v"(p1));
    float a = max3f(p0[0], p0[1], p1[0]), b = max3f(p0[2], p0[3], p1[1]); a = max3f(a, p1[2], p1[3]);
#pragma unroll
    for (int r = 4; r < 16; r += 4) { a = max3f(a, p0[r], p0[r + 1]); b = max3f(b, p0[r + 2], p0[r + 3]); a = max3f(a, p1[r], p1[r + 1]); b = max3f(b, p1[r + 2], p1[r + 3]); }
    const float m = max2f(a, b);
    return max2f(m, partner32(m, hi));
}
template <int NKI, int DV> struct Stager {
    u32x4 kreg[NKI], vreg[DV / 64];
    __device__ __forceinline__ void load(const bf16* P, int ldp, size_t rowbase, int kcol, int vcol, int tid) {
#pragma unroll
        for (int i = 0; i < NKI; ++i) { const int c = tid + 512 * i, row = c / (8 * NKI), ch = c % (8 * NKI);
            kreg[i] = *(const u32x4*)(P + (rowbase + row) * (size_t)ldp + kcol + ch * 8); }
#pragma unroll
        for (int i = 0; i < DV / 64; ++i) { const int c = tid + 512 * i, row = c / (DV / 8), ch = c % (DV / 8);
            vreg[i] = *(const u32x4*)(P + (rowbase + row) * (size_t)ldp + vcol + ch * 8); }
    }
    __device__ __forceinline__ void loadK(const bf16* P, int ldp, size_t rowbase, int kcol, int tid) {
#pragma unroll
        for (int i = 0; i < NKI; ++i) { const int c = tid + 512 * i, row = c / (8 * NKI), ch = c % (8 * NKI);
            kreg[i] = *(const u32x4*)(P + (rowbase + row) * (size_t)ldp + kcol + ch * 8); }
    }
    __device__ __forceinline__ void loadV(const bf16* P, int ldp, size_t rowbase, int vcol, int tid) {
#pragma unroll
        for (int i = 0; i < DV / 64; ++i) { const int c = tid + 512 * i, row = c / (DV / 8), ch = c % (DV / 8);
            vreg[i] = *(const u32x4*)(P + (rowbase + row) * (size_t)ldp + vcol + ch * 8); }
    }
    __device__ __forceinline__ void storeK(lptr kst, int tid) const {
#pragma unroll
        for (int i = 0; i < NKI; ++i) { const int c = tid + 512 * i, row = c / (8 * NKI), ch = c % (8 * NKI);
            *(LAS u32x4*)(kst + (ch >> 3) * KIMG + row * KROWB + (ch & 7) * 16) = kreg[i]; }
    }
    __device__ __forceinline__ void storeV(lptr vst, int tid) const {
#pragma unroll
        for (int i = 0; i < DV / 64; ++i) { const int c = tid + 512 * i, row = c / (DV / 8), ch = c % (DV / 8);
            *(LAS u32x4*)(vst + (ch >> 2) * 4096 + (row >> 3) * 512 + (row & 7) * 64 + (ch & 3) * 16) = vreg[i]; }
    }
    __device__ __forceinline__ void store(lptr st, int tid) const {
#pragma unroll
        for (int i = 0; i < NKI; ++i) { const int c = tid + 512 * i, row = c / (8 * NKI), ch = c % (8 * NKI);
            *(LAS u32x4*)(st + (ch >> 3) * KIMG + row * KROWB + (ch & 7) * 16) = kreg[i]; }
#pragma unroll
        for (int i = 0; i < DV / 64; ++i) { const int c = tid + 512 * i, row = c / (DV / 8), ch = c % (DV / 8);
            *(LAS u32x4*)(st + NKI * KIMG + (ch >> 2) * 4096 + (row >> 3) * 512 + (row & 7) * 64 + (ch & 3) * 16) = vreg[i]; }
    }
};

template <int DV> struct WaveAcc { f32x16 o[DV / 32]; float m, l;
    __device__ __forceinline__ void init() {
#pragma unroll
        for (int c = 0; c < DV / 32; ++c) o[c] = f32x16{};
        m = -INFINITY; l = 0.f; } };

template <int DV> __device__ __forceinline__ void sm_pv(WaveAcc<DV>& A, const u32x4 (&pw)[4], lptr vimg, int lane, int hi) {
    constexpr int NC = DV / 32;
    lptr vp = vimg + (4 * hi + ((lane & 15) >> 2)) * 64 + ((lane >> 4) & 1) * 32 + (lane & 3) * 8;
    bf16x8 f0[NC], f1[NC];
#define PV_READ(F, ks) _Pragma("unroll") for (int c = 0; c < NC; ++c) { const s16x4 lo = vtr(vp + c * 4096 + (ks) * 1024), h2 = vtr(vp + c * 4096 + (ks) * 1024 + 512); F[c] = __builtin_shufflevector(lo, h2, 0, 1, 2, 3, 4, 5, 6, 7); }
#define PV_MMA(F, ks) _Pragma("unroll") for (int c = 0; c < NC; ++c) A.o[c] = __builtin_amdgcn_mfma_f32_32x32x16_bf16(__builtin_bit_cast(bf16x8, pw[ks]), F[c], A.o[c], 0, 0, 0);
    PV_READ(f0, 0) PV_READ(f1, 1)
    __builtin_amdgcn_sched_barrier(0);
    PV_MMA(f0, 0)
    __builtin_amdgcn_sched_barrier(0);
    PV_READ(f0, 2)
    __builtin_amdgcn_sched_barrier(0);
    PV_MMA(f1, 1)
    __builtin_amdgcn_sched_barrier(0);
    PV_READ(f1, 3)
    __builtin_amdgcn_sched_barrier(0);
    PV_MMA(f0, 2)
    PV_MMA(f1, 3)
#undef PV_READ
#undef PV_MMA
}
template <int DV> __device__ __forceinline__ void sm_exp_pv_fused(WaveAcc<DV>& A, f32x16& p0, f32x16& p1, u32x4 (&pw_out)[4], const u32x4 (&pw_in)[4], lptr vimg, int lane, int hi) {
    constexpr int NC = DV / 32;
    constexpr int EPM = 32 / (4 * NC);
    lptr vp = vimg + (4 * hi + ((lane & 15) >> 2)) * 64 + ((lane >> 4) & 1) * 32 + (lane & 3) * 8;
    bf16x8 f0[NC], f1[NC];
#define PV_READ(F, ks) _Pragma("unroll") for (int c = 0; c < NC; ++c) { const s16x4 lo = vtr(vp + c * 4096 + (ks) * 1024), h2 = vtr(vp + c * 4096 + (ks) * 1024 + 512); F[c] = __builtin_shufflevector(lo, h2, 0, 1, 2, 3, 4, 5, 6, 7); }
#define PV_MMA_EXP(F, ks) _Pragma("unroll") for (int c = 0; c < NC; ++c) { \
        A.o[c] = __builtin_amdgcn_mfma_f32_32x32x16_bf16(__builtin_bit_cast(bf16x8, pw_in[ks]), F[c], A.o[c], 0, 0, 0); \
        _Pragma("unroll") for (int e = 0; e < EPM; ++e) { const int idx = ((ks) * NC + c) * EPM + e; if (idx < 16) p0[idx] = __builtin_amdgcn_exp2f(p0[idx]); else p1[idx - 16] = __builtin_amdgcn_exp2f(p1[idx - 16]); } \
        __builtin_amdgcn_sched_barrier(0); }
    PV_READ(f0, 0) PV_READ(f1, 1)
    __builtin_amdgcn_sched_barrier(0);
    PV_MMA_EXP(f0, 0)
    PV_READ(f0, 2)
    __builtin_amdgcn_sched_barrier(0);
    PV_MMA_EXP(f1, 1)
    PV_READ(f1, 3)
    __builtin_amdgcn_sched_barrier(0);
    PV_MMA_EXP(f0, 2)
    PV_MMA_EXP(f1, 3)
#undef PV_READ
#undef PV_MMA_EXP
    float s = 0.f;
#pragma unroll
    for (int r = 0; r < 16; ++r) s += p0[r] + p1[r];
    A.l += s;
#pragma unroll
    for (int k = 0; k < 2; ++k) {
        pw_out[k] = (u32x4){cvtpk(p0[8 * k + 0], p0[8 * k + 1]), cvtpk(p0[8 * k + 2], p0[8 * k + 3]), cvtpk(p0[8 * k + 4], p0[8 * k + 5]), cvtpk(p0[8 * k + 6], p0[8 * k + 7])};
        pw_out[2 + k] = (u32x4){cvtpk(p1[8 * k + 0], p1[8 * k + 1]), cvtpk(p1[8 * k + 2], p1[8 * k + 3]), cvtpk(p1[8 * k + 4], p1[8 * k + 5]), cvtpk(p1[8 * k + 6], p1[8 * k + 7])};
    }
}
__device__ __forceinline__ void qk_tile_rel(f32x16& p0, f32x16& p1, lptr kimg, const bf16x8 (&qr)[4], const f32x16& negm, int r32, int hi) {
    lptr kb = kimg + r32 * KROWB + hi * 16;
    bf16x8 a0[4], a1[4];
#pragma unroll
    for (int d0 = 0; d0 < 4; ++d0) { a0[d0] = *(LAS bf16x8*)(kb + d0 * 32); a1[d0] = *(LAS bf16x8*)(kb + 32 * KROWB + d0 * 32); }
    __builtin_amdgcn_sched_barrier(0);
#pragma unroll
    for (int d0 = 0; d0 < 4; ++d0) {
        p0 = __builtin_amdgcn_mfma_f32_32x32x16_bf16(a0[d0], qr[d0], d0 == 0 ? negm : p0, 0, 0, 0);
        p1 = __builtin_amdgcn_mfma_f32_32x32x16_bf16(a1[d0], qr[d0], d0 == 0 ? negm : p1, 0, 0, 0);
    }
}
template <int DV> __device__ __forceinline__ void sm_max_rel(WaveAcc<DV>& A, f32x16& p0, f32x16& p1, f32x16& negm, bool first, LAS float* wsf, int r32, int hi) {
    const float mx = rowmax32(p0, p1, hi);
    if (first || __any(mx > THR)) {
        const float dl = first ? mx : fmaxf(mx, 0.f);
        const float alpha = __builtin_amdgcn_exp2f(-dl);
        A.l *= alpha; A.m += dl;
#pragma unroll
        for (int r = 0; r < 16; ++r) { p0[r] -= dl; p1[r] -= dl; }
#pragma unroll
        for (int r = 0; r < 16; ++r) negm[r] = -A.m;
        if (hi == 0) wsf[r32] = alpha;
        asm volatile("" ::: "memory");
#pragma unroll
        for (int r = 0; r < 16; ++r) { const float a = wsf[crow(r, hi)];
#pragma unroll
            for (int c = 0; c < DV / 32; ++c) A.o[c][r] *= a; }
    }
}
template <int DV> __device__ __forceinline__ void sm_max_rel_pend(WaveAcc<DV>& A, f32x16& p0, f32x16& p1, f32x16& negm, bool first, u32x4 (&pw)[4], lptr vimg_prev, LAS float* wsf, int lane, int r32, int hi) {
    const float mx = rowmax32(p0, p1, hi);
    if (first || __any(mx > THR)) {
        sm_pv<DV>(A, pw, vimg_prev, lane, hi);
#pragma unroll
        for (int k = 0; k < 4; ++k) pw[k] = (u32x4){0u, 0u, 0u, 0u};
        const float dl = first ? mx : fmaxf(mx, 0.f);
        const float alpha = __builtin_amdgcn_exp2f(-dl);
        A.l *= alpha; A.m += dl;
#pragma unroll
        for (int r = 0; r < 16; ++r) { p0[r] -= dl; p1[r] -= dl; }
#pragma unroll
        for (int r = 0; r < 16; ++r) negm[r] = -A.m;
        if (hi == 0) wsf[r32] = alpha;
        asm volatile("" ::: "memory");
#pragma unroll
        for (int r = 0; r < 16; ++r) { const float a = wsf[crow(r, hi)];
#pragma unroll
            for (int c = 0; c < DV / 32; ++c) A.o[c][r] *= a; }
    }
}
template <int DV> __device__ __forceinline__ void sm_exp_rel(WaveAcc<DV>& A, f32x16& p0, f32x16& p1, u32x4 (&pw)[4]) {
    float s = 0.f;
#pragma unroll
    for (int r = 0; r < 16; ++r) { p0[r] = __builtin_amdgcn_exp2f(p0[r]); p1[r] = __builtin_amdgcn_exp2f(p1[r]); s += p0[r] + p1[r]; }
    A.l += s;
#pragma unroll
    for (int k = 0; k < 2; ++k) {
        pw[k] = (u32x4){cvtpk(p0[8 * k + 0], p0[8 * k + 1]), cvtpk(p0[8 * k + 2], p0[8 * k + 3]), cvtpk(p0[8 * k + 4], p0[8 * k + 5]), cvtpk(p0[8 * k + 6], p0[8 * k + 7])};
        pw[2 + k] = (u32x4){cvtpk(p1[8 * k + 0], p1[8 * k + 1]), cvtpk(p1[8 * k + 2], p1[8 * k + 3]), cvtpk(p1[8 * k + 4], p1[8 * k + 5]), cvtpk(p1[8 * k + 6], p1[8 * k + 7])};
    }
}
__device__ __forceinline__ void inv_rows(float (&invr)[16], float l, float extra, LAS float* wsf, int r32, int hi) {
    const float lt = l + partner32(l, hi) + extra;
    if (hi == 0) wsf[32 + r32] = 1.f / lt;
    __builtin_amdgcn_s_waitcnt(0xc07f); asm volatile("" ::: "memory");
#pragma unroll
    for (int r = 0; r < 16; ++r) invr[r] = wsf[32 + crow(r, hi)];
}
__device__ __forceinline__ void load_q(bf16x8 (&qr)[4], const bf16* P, int ldp, size_t qrow0, int qcol, int r32, int hi) {
#pragma unroll
    for (int d0 = 0; d0 < 4; ++d0) qr[d0] = *(const bf16x8*)(P + (qrow0 + r32) * (size_t)ldp + qcol + d0 * 16 + hi * 8);
}
__device__ __forceinline__ void store_o64(const WaveAcc<64>& A, const float (&invr)[16], bf16* O, size_t qrow0, int ocol, int r32, int hi) {
#pragma unroll
    for (int r = 0; r < 16; ++r)
#pragma unroll
        for (int c = 0; c < 2; ++c) O[(qrow0 + crow(r, hi)) * (size_t)DM + ocol + 32 * c + r32] = (bf16)f2bf(A.o[c][r] * invr[r]);
}

__device__ __forceinline__ void na_unit(bool isctx, int b, int h, int g4, const bf16* P, bf16* O, const float* rpb, LAS unsigned char* lds) {
    int tid = threadIdx.x; asm volatile("" : "+v"(tid));
    const int lane = tid & 63, r32 = lane & 31, hi = lane >> 5, w = __builtin_amdgcn_readfirstlane(tid >> 6);
    LAS float* rpbl = (LAS float*)(lds + L_RPB); LAS float* wsf = (LAS float*)(lds + L_WSF) + w * 64;
    for (int i = tid; i < 15 * 31; i += 512) rpbl[i] = rpb[h * 465 + i] * LOG2E;
    const size_t ctx0 = (size_t)TL + (size_t)b * CTXL;
    const int qgr = 4 * g4 + (w >> 1), qcb = 32 * (w & 1);
    const size_t qrow0 = isctx ? ctx0 + 32 * w : (size_t)b * SEQ + qgr * 64 + qcb;
    bf16x8 qr[4]; load_q(qr, P, EVEN_IN, qrow0, h * 64, r32, hi);
    const int kr_lo = max(4 * g4 - 4, 0), kr_hi = min(max(4 * g4 - 1, 0), 248) + 8;
    const int nt = isctx ? 4 : 4 + (kr_hi - kr_lo);
    const int rs = min(max(qgr - 4, 0), 248);
    const int kcol = 512 + h * 64, vcol = 1024 + h * 64;
    WaveAcc<64> A; A.init(); A.m = 0.f; f32x16 negm = f32x16{};
    Stager<1, 64> sg;
#define NA_ROWBASE(t) ((t) < 4 ? ctx0 + 64 * (t) : (size_t)b * SEQ + (size_t)(kr_lo + (t) - 4) * 64)
    sg.load(P, EVEN_IN, NA_ROWBASE(0), kcol, vcol, tid); sg.store(lds, tid);
    if (nt > 1) sg.load(P, EVEN_IN, NA_ROWBASE(1), kcol, vcol, tid);
    for (int t = 0; t < nt; ++t) {
        __syncthreads();
        if (t + 1 < nt) { sg.store(lds + ((t + 1) & 1) * ST_BYTES, tid); if (t + 2 < nt) sg.load(P, EVEN_IN, NA_ROWBASE(t + 2), kcol, vcol, tid); }
        lptr st = lds + (t & 1) * ST_BYTES;
        const int kr = kr_lo + t - 4;
        if (t < 4 || (kr >= rs && kr < rs + 8)) {
            f32x16 p0, p1; qk_tile_rel(p0, p1, st, qr, negm, r32, hi);
            if (t >= 4) {
                const int qc = qcb + r32; int cs4 = min(max(qc - 8, 0), 48) - 4 * hi;
                asm volatile("" : "+v"(cs4));
                LAS const float* bl = rpbl + (kr - qgr + 7) * 31 + (15 - qc + 4 * hi);
#pragma unroll
                for (int r = 0; r < 16; ++r) {
                    const int kk = (r & 3) + 8 * (r >> 2);
                    p0[r] = ((unsigned)(kk - cs4) < 16u) ? p0[r] + bl[kk] : -INFINITY;
                    p1[r] = ((unsigned)(kk + 32 - cs4) < 16u) ? p1[r] + bl[kk + 32] : -INFINITY;
                }
            }
            sm_max_rel<64>(A, p0, p1, negm, t == 0, wsf, r32, hi);
            u32x4 pw[4]; sm_exp_rel<64>(A, p0, p1, pw);
            sm_pv<64>(A, pw, st + KIMG, lane, hi);
        }
    }
#undef NA_ROWBASE
    float invr[16]; inv_rows(invr, A.l, 0.f, wsf, r32, hi);
    store_o64(A, invr, O, qrow0, h * 64, r32, hi);
    __syncthreads();
}

__device__ __forceinline__ void swa_unit(bool isctx, int b, int n, int qb, const bf16* P, bf16* O, const float* sink, LAS unsigned char* lds) {
    int tid = threadIdx.x; asm volatile("" : "+v"(tid));
    const int lane = tid & 63, r32 = lane & 31, hi = lane >> 5, w = __builtin_amdgcn_readfirstlane(tid >> 6);
    LAS float* wsf = (LAS float*)(lds + L_WSF) + w * 64;
    const size_t ctx0 = (size_t)TL + (size_t)b * CTXL;
    const int hq = 4 * n + (w >> 1), j = w & 1, q0 = 64 * qb;
    const size_t qrow0 = isctx ? ctx0 + q0 + 32 * j : (size_t)b * SEQ + q0 + 32 * j;
    bf16x8 qr[4]; load_q(qr, P, ODD_IN, qrow0, hq * 64, r32, hi);
    const int jlo = q0 >= 128 ? 0 : (128 - q0) / 64, jhi = min(5, (SEQ - q0 + 128) / 64);
    const int nt = isctx ? 4 : 4 + (jhi - jlo);
    const int kcol = 1024 + n * 64, vcol = 1280 + n * 64;
    WaveAcc<64> A; A.init(); A.m = 0.f; f32x16 negm = f32x16{};
    Stager<1, 64> sg;
#define SWA_KPOS0(t) (q0 - 128 + 64 * (jlo + (t) - 4))
#define SWA_ROWBASE(t) ((t) < 4 ? ctx0 + 64 * (t) : (size_t)b * SEQ + (size_t)SWA_KPOS0(t))
    sg.load(P, ODD_IN, SWA_ROWBASE(0), kcol, vcol, tid); sg.store(lds, tid);
    if (nt > 1) sg.load(P, ODD_IN, SWA_ROWBASE(1), kcol, vcol, tid);
    for (int t = 0; t < nt; ++t) {
        __syncthreads();
        if (t + 1 < nt) { sg.store(lds + ((t + 1) & 1) * ST_BYTES, tid); if (t + 2 < nt) sg.load(P, ODD_IN, SWA_ROWBASE(t + 2), kcol, vcol, tid); }
        lptr st = lds + (t & 1) * ST_BYTES;
        f32x16 p0, p1; qk_tile_rel(p0, p1, st, qr, negm, r32, hi);
        if (t >= 4) {
            const int dbase = SWA_KPOS0(t) - (q0 + 32 * j + r32) + 128;
#pragma unroll
            for (int r = 0; r < 16; ++r) {
                const int k0 = crow(r, hi);
                p0[r] = ((unsigned)(dbase + k0) <= 256u) ? p0[r] : -INFINITY;
                p1[r] = ((unsigned)(dbase + k0 + 32) <= 256u) ? p1[r] : -INFINITY;
            }
        }
        sm_max_rel<64>(A, p0, p1, negm, t == 0, wsf, r32, hi);
        u32x4 pw[4]; sm_exp_rel<64>(A, p0, p1, pw);
        sm_pv<64>(A, pw, st + KIMG, lane, hi);
    }
#undef SWA_ROWBASE
#undef SWA_KPOS0
    float invr[16]; inv_rows(invr, A.l, __builtin_amdgcn_exp2f(sink[hq] * LOG2E - A.m), wsf, r32, hi);
    store_o64(A, invr, O, qrow0, hq * 64, r32, hi);
    __syncthreads();
}

__device__ __forceinline__ void diff_unit(bool isctx, int b, int h, int qb, const bf16* P, bf16* O, float lam, float osc, const float* subg, LAS unsigned char* lds, unsigned long long& probe_acc) {
    const bool probe_on = MK_PROBE != 0 && blockIdx.x == 0 && __builtin_amdgcn_readfirstlane(threadIdx.x >> 6) == 0;
    int tid = threadIdx.x; asm volatile("" : "+v"(tid));
    const int lane = tid & 63, r32 = lane & 31, hi = lane >> 5, w = __builtin_amdgcn_readfirstlane(tid >> 6);
    LAS float* wsf = (LAS float*)(lds + L_WSF) + w * 64;
    const size_t ctx0 = (size_t)TL + (size_t)b * CTXL;
    const int mp = w >> 2, qg = w & 3;
    const size_t qrow0 = (isctx ? ctx0 : (size_t)b * SEQ) + 128 * qb + 32 * qg;
    bf16x8 qr[4]; load_q(qr, P, EVEN_IN, qrow0, 1536 + h * 128 + mp * 64, r32, hi);
    const int nt = isctx ? 4 : 4 + SEQ / 64;
    const int kcol = 2048 + h * 128, vcol = 2560 + h * 128;
    WaveAcc<128> A; A.init();
    Stager<2, 128> sg;
#define DF_ROWBASE(t) ((t) < 4 ? ctx0 + 64 * (t) : (size_t)b * SEQ + (size_t)((t) - 4) * 64)
    A.m = 0.f; f32x16 negm = f32x16{};
    sg.load(P, EVEN_IN, DF_ROWBASE(0), kcol, vcol, tid); sg.store(lds, tid);
    sg.load(P, EVEN_IN, DF_ROWBASE(1), kcol, vcol, tid);
    u32x4 pw[4] = {};
    int s_prev = 2 * ST_BYTES, s_cur = 0, s_nxt = ST_BYTES;
    for (int t = 0; t < nt; ++t) {
        __syncthreads();
        if (t + 1 < nt) { sg.store(lds + s_nxt, tid); if (t + 2 < nt) sg.load(P, EVEN_IN, DF_ROWBASE(t + 2), kcol, vcol, tid); }
        f32x16 p0, p1; qk_tile_rel(p0, p1, lds + s_cur + mp * KIMG, qr, negm, r32, hi);
        lptr vprev = lds + (t == 0 ? s_cur : s_prev) + 2 * KIMG;
        sm_max_rel_pend<128>(A, p0, p1, negm, t == 0, pw, vprev, wsf, lane, r32, hi);
        u32x4 pwn[4]; sm_exp_pv_fused<128>(A, p0, p1, pwn, pw, vprev, lane, hi);
#pragma unroll
        for (int k = 0; k < 4; ++k) pw[k] = pwn[k];
        const int tmp = s_prev; s_prev = s_cur; s_cur = s_nxt; s_nxt = tmp;
    }
    sm_pv<128>(A, pw, lds + s_prev + 2 * KIMG, lane, hi);
#undef DF_ROWBASE
    float invr[16]; inv_rows(invr, A.l, 0.f, wsf, r32, hi);
    __syncthreads();
    LAS float* xch = (LAS float*)lds + qg * 4096;
    if (mp == 1) {
#pragma unroll
        for (int r = 0; r < 16; ++r)
#pragma unroll
            for (int c = 0; c < 4; ++c) xch[crow(r, hi) * 128 + 32 * c + r32] = A.o[c][r] * invr[r];
    }
    __syncthreads();
    if (mp == 0) {
        float gsub[4];
#pragma unroll
        for (int c = 0; c < 4; ++c) gsub[c] = subg[32 * c + r32] * osc;
#pragma unroll
        for (int r = 0; r < 16; ++r) {
            float ss = 0.f;
#pragma unroll
            for (int c = 0; c < 4; ++c) { const float v = A.o[c][r] * invr[r] - lam * xch[crow(r, hi) * 128 + 32 * c + r32]; A.o[c][r] = v; ss += v * v; }
#pragma unroll
            for (int o = 1; o < 32; o <<= 1) ss += __shfl_xor(ss, o);
            const float rs = __builtin_amdgcn_rsqf(ss * (1.f / 128.f) + EPS);
#pragma unroll
            for (int c = 0; c < 4; ++c) O[(qrow0 + crow(r, hi)) * (size_t)DM + 512 + h * 128 + 32 * c + r32] = (bf16)f2bf(A.o[c][r] * rs * gsub[c]);
        }
    }
    __syncthreads();
}
}

namespace peer {
typedef short bf16x8 __attribute__((ext_vector_type(8)));
typedef float f32x16 __attribute__((ext_vector_type(16)));
typedef unsigned u32x4 __attribute__((ext_vector_type(4)));
constexpr int KEYROWB = 272, KEYIMG = 128 * KEYROWB;
constexpr int L_KEYS = 0, L_TAB = 2 * KEYIMG;
static_assert(L_TAB + NWAVES * 2048 <= RING_BYTES, "peer LDS");

__device__ __forceinline__ void cex(float& a, float& b) { const float mx = fmaxf(a, b), mn = fminf(a, b); a = mx; b = mn; }
template <int OFF> __device__ __forceinline__ void sort16(float (&v)[64]) {
#pragma unroll
    for (int k = 2; k <= 16; k <<= 1)
#pragma unroll
        for (int j = k >> 1; j > 0; j >>= 1)
#pragma unroll
            for (int i = 0; i < 16; ++i) { const int l = i ^ j; if (l > i) { if ((i & k) == 0) cex(v[OFF + i], v[OFF + l]); else cex(v[OFF + l], v[OFF + i]); } }
}
__device__ __forceinline__ void merge16(float (&t)[16]) {
#pragma unroll
    for (int j = 8; j > 0; j >>= 1)
#pragma unroll
        for (int i = 0; i < 16; ++i) { const int l = i ^ j; if (l > i) cex(t[i], t[l]); }
}
__device__ __forceinline__ void top16_of_64(float (&v)[64], float (&out)[16]) {
    sort16<0>(v); sort16<16>(v); sort16<32>(v); sort16<48>(v);
    float a[16], b[16];
#pragma unroll
    for (int i = 0; i < 16; ++i) { a[i] = fmaxf(v[i], v[31 - i]); b[i] = fmaxf(v[32 + i], v[63 - i]); }
    merge16(a); merge16(b);
#pragma unroll
    for (int i = 0; i < 16; ++i) out[i] = fmaxf(a[i], b[15 - i]);
    merge16(out);
}
struct CandTab { int pos[16][16]; int n;
    constexpr CandTab() : pos{}, n(0) { for (int x = 0; x < 16; ++x) for (int y = 0; y < 16; ++y) { pos[x][y] = n; if ((x + 1) * (y + 1) <= 16) ++n; } } };
constexpr CandTab CT{};
static_assert(CT.n == 50, "50 candidate pairs");
template <int A, int B> struct CandPos { static constexpr int value = CT.pos[A][B]; };

template <int A, int B> __device__ __forceinline__ void cand_fill(float (&c)[64], const float (&top)[2][16]) {
    if constexpr ((A + 1) * (B + 1) <= 16) {
        const float s = __uint_as_float(__float_as_uint(top[0][A]) & ~127u) + __uint_as_float(__float_as_uint(top[1][B]) & ~127u);
        c[CT.pos[A][B]] = __uint_as_float((__float_as_uint(s) & ~255u) | (unsigned)(A * 16 + B));
    }
    if constexpr (B < 15) cand_fill<A, B + 1>(c, top);
    else if constexpr (A < 15) cand_fill<A + 1, 0>(c, top);
}
__device__ __forceinline__ void topk_wave(const bf16* PQ, size_t tok0, int h, LAS unsigned char* keys, LAS unsigned* tab, int* IDX, float* GATE, int lane) {
    const int r32 = lane & 31, hi = lane >> 5;
    float top[2][16];
#pragma unroll
    for (int p = 0; p < 2; ++p) {
        bf16x8 qf[8];
#pragma unroll
        for (int ks = 0; ks < 8; ++ks) qf[ks] = *(const bf16x8*)(PQ + (tok0 + r32) * (size_t)PQ_N + h * 256 + p * 128 + ks * 16 + hi * 8);
        float v[64];
#pragma unroll
        for (int nb = 0; nb < 4; ++nb) {
            f32x16 acc = f32x16{};
            LAS unsigned char* kb = keys + p * KEYIMG + (32 * nb + r32) * KEYROWB + hi * 16;
#pragma unroll
            for (int ks = 0; ks < 8; ++ks) acc = __builtin_amdgcn_mfma_f32_32x32x16_bf16(*(LAS bf16x8*)(kb + ks * 32), qf[ks], acc, 0, 0, 0);
#pragma unroll
            for (int r = 0; r < 16; ++r) { const unsigned n = 32 * nb + (r & 3) + 8 * (r >> 2) + 4 * hi; v[16 * nb + r] = __uint_as_float((__float_as_uint(acc[r]) & ~127u) | n); }
        }
        float mine[16]; top16_of_64(v, mine);
#pragma unroll
        for (int i = 0; i < 16; ++i) { const float o = att::partner32(mine[15 - i], hi); top[p][i] = fmaxf(mine[i], o); }
        merge16(top[p]);
    }
#pragma unroll
    for (int p = 0; p < 2; ++p)
#pragma unroll
        for (int j = 0; j < 4; ++j) {
            unsigned wv = 0;
#pragma unroll
            for (int e = 0; e < 4; ++e) wv |= (__float_as_uint(top[p][4 * j + e]) & 127u) << (8 * e);
            tab[(4 * p + j) * 64 + lane] = wv;
        }
    float c[64];
#pragma unroll
    for (int i = 0; i < 64; ++i) c[i] = -INFINITY;
    cand_fill<0, 0>(c, top);
    float res[16]; top16_of_64(c, res);
    float fv[16]; int eid[16];
    float mx = -INFINITY;
#pragma unroll
    for (int k = 0; k < 16; ++k) {
        const unsigned bits = __float_as_uint(res[k]); const unsigned a = (bits >> 4) & 15u, b = bits & 15u;
        const unsigned w1 = tab[(a >> 2) * 64 + lane], w2 = tab[(4 + (b >> 2)) * 64 + lane];
        const unsigned i1 = (w1 >> (8 * (a & 3))) & 127u, i2 = (w2 >> (8 * (b & 3))) & 127u;
        eid[k] = (int)(i1 * 128u + i2); fv[k] = __uint_as_float(bits & ~255u); mx = fmaxf(mx, fv[k]);
    }
    float sum = 0.f;
#pragma unroll
    for (int k = 0; k < 16; ++k) { fv[k] = __builtin_amdgcn_exp2f((fv[k] - mx) * LOG2E); sum += fv[k]; }
    const float inv = 1.f / sum;
    int* ip = IDX + (tok0 + r32) * 128 + h * 16; float* gp = GATE + (tok0 + r32) * 128 + h * 16;
#pragma unroll
    for (int k = 0; k < 16; ++k) fv[k] *= inv;
    if (hi == 0) {
        *(int4*)(ip) = make_int4(eid[0], eid[1], eid[2], eid[3]); *(int4*)(ip + 4) = make_int4(eid[4], eid[5], eid[6], eid[7]);
        *(float4*)(gp) = make_float4(fv[0], fv[1], fv[2], fv[3]); *(float4*)(gp + 4) = make_float4(fv[4], fv[5], fv[6], fv[7]);
    } else {
        *(int4*)(ip + 8) = make_int4(eid[8], eid[9], eid[10], eid[11]); *(int4*)(ip + 12) = make_int4(eid[12], eid[13], eid[14], eid[15]);
        *(float4*)(gp + 8) = make_float4(fv[8], fv[9], fv[10], fv[11]); *(float4*)(gp + 12) = make_float4(fv[12], fv[13], fv[14], fv[15]);
    }
}

__device__ __forceinline__ float gelu_f(float v) {
    const float av = fabsf(v), t = __builtin_amdgcn_rcpf(av * 0.2316418882f + 1.0f);
    float q = t * 0.5307027145f + (-0.7265760135f); q = q * t + 0.7107068705f; q = q * t + (-0.142248368f); q = q * t + 0.127414796f; q = q * t;
    const float e = __builtin_amdgcn_exp2f((v * v) * (-0.72134752044f));
    const float m = v * (q * e);
    return v < 0.f ? m : v - m;
}
typedef float f2 __attribute__((ext_vector_type(2)));
constexpr float U4_SCALE = 64.f, V4_SCALE = 8.f;
__device__ __forceinline__ void expert_token4(const bf16* Hrow, const int* idx, const float* gate, const unsigned char* UV4, f2 (&f)[8], int lane) {
    f2 hv[8];
    { const u32x4 h0 = *(const u32x4*)(Hrow + 16 * lane), h1 = *(const u32x4*)(Hrow + 16 * lane + 8);
      const unsigned hw[8] = {h0.x, h0.y, h0.z, h0.w, h1.x, h1.y, h1.z, h1.w};
#pragma unroll
      for (int i = 0; i < 8; ++i) hv[i] = (f2){__uint_as_float(hw[i] << 16), __uint_as_float(hw[i] & 0xffff0000u)}; }
    const int i0 = idx[lane], i1 = idx[64 + lane];
    const float g0 = gate[lane], g1 = gate[64 + lane];
#pragma unroll
    for (int i = 0; i < 8; ++i) f[i] = (f2){0.f, 0.f};
#pragma nounroll
    for (int g = 0; g < 8; ++g) {
        const int ireg = g < 4 ? i0 : i1; const float greg = g < 4 ? g0 : g1;
        u32x4 rq[16];
#pragma unroll
        for (int k = 0; k < 16; ++k) { const unsigned e = (unsigned)__builtin_amdgcn_readlane(ireg, (g * 16 + k) & 63); rq[k] = *(const u32x4*)(UV4 + ((size_t)e * 64 + lane) * 16); }
        float d[16];
#pragma unroll
        for (int k = 0; k < 16; ++k) { const unsigned w0 = rq[k].x, w1 = rq[k].y;
            f2 a = hv[0] * __builtin_amdgcn_cvt_scalef32_pk_f32_fp4(w0, 1.0f, 0);
            a += hv[1] * __builtin_amdgcn_cvt_scalef32_pk_f32_fp4(w0, 1.0f, 1);
            a += hv[2] * __builtin_amdgcn_cvt_scalef32_pk_f32_fp4(w0, 1.0f, 2);
            a += hv[3] * __builtin_amdgcn_cvt_scalef32_pk_f32_fp4(w0, 1.0f, 3);
            a += hv[4] * __builtin_amdgcn_cvt_scalef32_pk_f32_fp4(w1, 1.0f, 0);
            a += hv[5] * __builtin_amdgcn_cvt_scalef32_pk_f32_fp4(w1, 1.0f, 1);
            a += hv[6] * __builtin_amdgcn_cvt_scalef32_pk_f32_fp4(w1, 1.0f, 2);
            a += hv[7] * __builtin_amdgcn_cvt_scalef32_pk_f32_fp4(w1, 1.0f, 3);
            d[k] = a.x + a.y; }
        float d8[8];
#pragma unroll
        for (int k = 0; k < 8; ++k) { const bool up = (lane & 32) != 0; const float keep = up ? d[8 + k] : d[k], send = up ? d[k] : d[8 + k]; d8[k] = keep + __shfl_xor(send, 32); }
        float d4[4];
#pragma unroll
        for (int k = 0; k < 4; ++k) { const bool up = (lane & 16) != 0; const float keep = up ? d8[4 + k] : d8[k], send = up ? d8[k] : d8[4 + k]; d4[k] = keep + __shfl_xor(send, 16); }
        float d2[2];
#pragma unroll
        for (int k = 0; k < 2; ++k) { const bool up = (lane & 8) != 0; const float keep = up ? d4[2 + k] : d4[k], send = up ? d4[k] : d4[2 + k]; d2[k] = keep + __shfl_xor(send, 8); }
        float d1; { const bool up = (lane & 4) != 0; const float keep = up ? d2[1] : d2[0], send = up ? d2[0] : d2[1]; d1 = keep + __shfl_xor(send, 4); }
        d1 += __shfl_xor(d1, 2); d1 += __shfl_xor(d1, 1);
        const float gk = __shfl(greg, (g * 16 + ((lane >> 2) & 15)) & 63);
        const float wv = gk * gelu_f(d1 * (1.f / U4_SCALE)) * (1.f / V4_SCALE);
#pragma unroll
        for (int k = 0; k < 16; ++k) { const float wk = __uint_as_float(__builtin_amdgcn_readlane(__float_as_uint(wv), 4 * k)); const f2 ww = {wk, wk};
            const unsigned w0 = rq[k].z, w1 = rq[k].w;
            f[0] += ww * __builtin_amdgcn_cvt_scalef32_pk_f32_fp4(w0, 1.0f, 0); f[1] += ww * __builtin_amdgcn_cvt_scalef32_pk_f32_fp4(w0, 1.0f, 1);
            f[2] += ww * __builtin_amdgcn_cvt_scalef32_pk_f32_fp4(w0, 1.0f, 2); f[3] += ww * __builtin_amdgcn_cvt_scalef32_pk_f32_fp4(w0, 1.0f, 3);
            f[4] += ww * __builtin_amdgcn_cvt_scalef32_pk_f32_fp4(w1, 1.0f, 0); f[5] += ww * __builtin_amdgcn_cvt_scalef32_pk_f32_fp4(w1, 1.0f, 1);
            f[6] += ww * __builtin_amdgcn_cvt_scalef32_pk_f32_fp4(w1, 1.0f, 2); f[7] += ww * __builtin_amdgcn_cvt_scalef32_pk_f32_fp4(w1, 1.0f, 3); }
    }
}
}

struct Frame {
    LAS unsigned char* lds;
    int tid, lane, wave, vcu, G;
};
__device__ __forceinline__ void p0_transpose_item(const float* W, int K, int N, bf16* WT, LAS float* scr, int item, int lane) {
    const int nblk = N / 32, kb = item / nblk, nb = item % nblk, k0 = 64 * kb, n0 = 32 * nb;
#pragma unroll 8
    for (int i = 0; i < 32; ++i) { const int kk = 2 * i + (lane >> 5); scr[kk * 33 + (lane & 31)] = W[(size_t)(k0 + kk) * N + n0 + (lane & 31)]; }
    LDS_WAIT(); asm volatile("" ::: "memory");
    const int c = lane & 7;
#pragma unroll
    for (int j = 0; j < 4; ++j) { const int n = (lane >> 3) + 8 * j; const LAS float* s = scr + (8 * c) * 33 + n;
        v4u o; o.x = pk2(s[0 * 33], s[1 * 33]); o.y = pk2(s[2 * 33], s[3 * 33]); o.z = pk2(s[4 * 33], s[5 * 33]); o.w = pk2(s[6 * 33], s[7 * 33]);
        *(GAS v4u*)(WT + (size_t)(n0 + n) * K + k0 + 8 * c) = o; }
    LDS_WAIT(); asm volatile("" ::: "memory");
}
__device__ __forceinline__ void cvt_copy(const float* src, bf16* dst, size_t n8, size_t gtid, size_t nthr) {
    for (size_t i = gtid; i < n8; i += nthr) {
        const f32x4 a = *(const f32x4*)(src + i * 8), b = *(const f32x4*)(src + i * 8 + 4);
        v4u o; o.x = pk2(a.x, a.y); o.y = pk2(a.z, a.w); o.z = pk2(b.x, b.y); o.w = pk2(b.z, b.w);
        *(v4u*)(dst + i * 8) = o;
    }
}
__device__ __forceinline__ void cvt_fp4(const float* U, const float* V, unsigned char* dst, size_t nblk, float su, float sv, size_t gtid, size_t nthr) {
    for (size_t i = gtid; i < nblk; i += nthr) {
        unsigned w[4] = {0u, 0u, 0u, 0u};
#pragma unroll
        for (int q = 0; q < 4; ++q) { const f32x4 a = *(const f32x4*)(U + i * 16 + q * 4) * su, b = *(const f32x4*)(V + i * 16 + q * 4) * sv;
            if (q == 0) { w[0] = __builtin_amdgcn_cvt_scalef32_pk_fp4_f32(w[0], a.x, a.y, 1.0f, 0); w[0] = __builtin_amdgcn_cvt_scalef32_pk_fp4_f32(w[0], a.z, a.w, 1.0f, 1);
                          w[2] = __builtin_amdgcn_cvt_scalef32_pk_fp4_f32(w[2], b.x, b.y, 1.0f, 0); w[2] = __builtin_amdgcn_cvt_scalef32_pk_fp4_f32(w[2], b.z, b.w, 1.0f, 1); }
            if (q == 1) { w[0] = __builtin_amdgcn_cvt_scalef32_pk_fp4_f32(w[0], a.x, a.y, 1.0f, 2); w[0] = __builtin_amdgcn_cvt_scalef32_pk_fp4_f32(w[0], a.z, a.w, 1.0f, 3);
                          w[2] = __builtin_amdgcn_cvt_scalef32_pk_fp4_f32(w[2], b.x, b.y, 1.0f, 2); w[2] = __builtin_amdgcn_cvt_scalef32_pk_fp4_f32(w[2], b.z, b.w, 1.0f, 3); }
            if (q == 2) { w[1] = __builtin_amdgcn_cvt_scalef32_pk_fp4_f32(w[1], a.x, a.y, 1.0f, 0); w[1] = __builtin_amdgcn_cvt_scalef32_pk_fp4_f32(w[1], a.z, a.w, 1.0f, 1);
                          w[3] = __builtin_amdgcn_cvt_scalef32_pk_fp4_f32(w[3], b.x, b.y, 1.0f, 0); w[3] = __builtin_amdgcn_cvt_scalef32_pk_fp4_f32(w[3], b.z, b.w, 1.0f, 1); }
            if (q == 3) { w[1] = __builtin_amdgcn_cvt_scalef32_pk_fp4_f32(w[1], a.x, a.y, 1.0f, 2); w[1] = __builtin_amdgcn_cvt_scalef32_pk_fp4_f32(w[1], a.z, a.w, 1.0f, 3);
                          w[3] = __builtin_amdgcn_cvt_scalef32_pk_fp4_f32(w[3], b.x, b.y, 1.0f, 2); w[3] = __builtin_amdgcn_cvt_scalef32_pk_fp4_f32(w[3], b.z, b.w, 1.0f, 3); }
        }
        *(v4u*)(dst + i * 16) = (v4u){w[0], w[1], w[2], w[3]};
    }
}
__device__ __forceinline__ float silu_f(float x) { return x / (1.f + __expf(-x)); }

struct Args { const float* in[21]; float* out; unsigned char* ws; int ph_lo, ph_hi; };
static_assert(offsetof(Args, out) == 168 && offsetof(Args, ws) == 176 && sizeof(Args) == 192, "kernarg offsets used by INP / WSL");
enum { IN_X = 0, IN_C, IN_CTX, IN_CCTX, IN_WMOD, IN_BMOD, IN_N1G, IN_N2G, IN_WIE, IN_WOE, IN_RPB, IN_DLAM, IN_SUBG, IN_WIO, IN_WOO, IN_SINK, IN_WQ, IN_KEYS, IN_U, IN_V, IN_FG };

__device__ __forceinline__ void load_xrow_bf(const bf16* xrow, f32x4 (&v)[4], int lane) {
    typedef unsigned u32x2 __attribute__((ext_vector_type(2)));
#pragma unroll
    for (int j = 0; j < 4; ++j) { const u32x2 w = ((const u32x2*)xrow)[lane + 64 * j];
        v[j] = (f32x4){__uint_as_float(w.x << 16), __uint_as_float(w.x & 0xffff0000u), __uint_as_float(w.y << 16), __uint_as_float(w.y & 0xffff0000u)}; }
}
__device__ __forceinline__ void norm_row_x2(const bf16* xa, const bf16* xb, const float* g, const float* ma_scale, const float* ma_shift, const float* mb_scale, const float* mb_shift, bf16* oa, bf16* ob, int lane) {
    f32x4 va[4], vb[4]; float sa = 0.f, sb = 0.f;
    load_xrow_bf(xa, va, lane); load_xrow_bf(xb, vb, lane);
#pragma unroll
    for (int j = 0; j < 4; ++j) { sa += (va[j].x * va[j].x + va[j].y * va[j].y) + (va[j].z * va[j].z + va[j].w * va[j].w); sb += (vb[j].x * vb[j].x + vb[j].y * vb[j].y) + (vb[j].z * vb[j].z + vb[j].w * vb[j].w); }
#pragma unroll
    for (int o = 1; o < 64; o <<= 1) { sa += __shfl_xor(sa, o); sb += __shfl_xor(sb, o); }
    const float ra = __builtin_amdgcn_rsqf(sa * (1.f / DM) + EPS), rb = __builtin_amdgcn_rsqf(sb * (1.f / DM) + EPS);
#pragma unroll
    for (int j = 0; j < 4; ++j) {
        const f32x4 gg = ((const f32x4*)g)[lane + 64 * j];
        const f32x4 ya = va[j] * ra * gg * (((const f32x4*)ma_scale)[lane + 64 * j] + 1.f) + ((const f32x4*)ma_shift)[lane + 64 * j];
        const f32x4 yb = vb[j] * rb * gg * (((const f32x4*)mb_scale)[lane + 64 * j] + 1.f) + ((const f32x4*)mb_shift)[lane + 64 * j];
        ((unsigned long long*)oa)[lane + 64 * j] = (unsigned long long)pk2(ya.x, ya.y) | ((unsigned long long)pk2(ya.z, ya.w) << 32);
        ((unsigned long long*)ob)[lane + 64 * j] = (unsigned long long)pk2(yb.x, yb.y) | ((unsigned long long)pk2(yb.z, yb.w) << 32);
    }
}
template <int MODE, bool XBF = false> __device__ __forceinline__ void norm_row(const void* xrow, const float* g, const float* scale, const float* shift, bf16* ob, float* of, int lane) {
    f32x4 v[4]; float s = 0.f;
    if (XBF) load_xrow_bf((const bf16*)xrow, v, lane);
    else { const f32x4* xr = (const f32x4*)xrow + lane;
#pragma unroll
        for (int j = 0; j < 4; ++j) v[j] = xr[64 * j]; }
#pragma unroll
    for (int j = 0; j < 4; ++j) s += (v[j].x * v[j].x + v[j].y * v[j].y) + (v[j].z * v[j].z + v[j].w * v[j].w);
    const float rstd = __builtin_amdgcn_rsqf(wave_sum(s) * (1.f / DM) + EPS);
#pragma unroll
    for (int j = 0; j < 4; ++j) {
        const f32x4 gg = ((const f32x4*)g)[lane + 64 * j];
        f32x4 y = v[j] * rstd * gg;
        if (MODE == 0) {
            const f32x4 sc = ((const f32x4*)scale)[lane + 64 * j], sh = ((const f32x4*)shift)[lane + 64 * j];
            y = y * (sc + 1.f) + sh;
            ((unsigned long long*)ob)[lane + 64 * j] = (unsigned long long)pk2(y.x, y.y) | ((unsigned long long)pk2(y.z, y.w) << 32);
        } else ((f32x4*)of)[lane + 64 * j] = y;
    }
}
constexpr int NPHASES = 2 + 8 * DEPTH;
#ifndef MK_PER_PHASE
#define MK_PER_PHASE 0
#endif
#ifndef MK_KINDS
#define MK_KINDS 0x3FF
#endif
#define KIND_EN(c) (((MK_KINDS) >> (c)) & 1)
#ifndef MK_REPEAT
#define MK_REPEAT 0
#endif
#ifndef MK_SKIP
#define MK_SKIP 0
#endif

__global__ void __launch_bounds__(NWAVES * 64, 2) fwd(Args args) {
    extern __shared__ __attribute__((aligned(16))) unsigned char lds_raw[];
    Frame F;
    F.lds = (LAS unsigned char*)lds_raw;
    F.tid = threadIdx.x; F.lane = F.tid & 63; F.wave = __builtin_amdgcn_readfirstlane(F.tid >> 6);
    F.G = gridDim.x; { const int bx = blockIdx.x; F.vcu = (F.G % 8 == 0) ? (bx % 8) * (F.G / 8) + bx / 8 : bx; }
    unsigned char* ws = args.ws;
    gu32* ctl = (gu32*)(ws + WS_CTL);
    for (int u = F.tid; u < (LDS_BYTES - LDSCTL_OFF) / 4; u += NWAVES * 64) ((LAS unsigned*)(F.lds + LDSCTL_OFF))[u] = 0u;
    __syncthreads();
    XcdBarrier bar = xcd_barrier_post((unsigned*)ctl + CW_BAR, (volatile LAS unsigned*)(F.lds + MISC_OFF) + 8);

typedef const float* cfptr_t; typedef float* fptr_t; typedef unsigned char* ucptr_t;
typedef __attribute__((address_space(4))) const unsigned char* kargp_t;
#define KARG(T, off) (*(__attribute__((address_space(4))) const T*)(kp_ + (off)))
#define INP(i) ((const float*)(const GAS float*)KARG(cfptr_t, 8 * (i)))
#define WSL kargp_t kp_ = (kargp_t)__builtin_amdgcn_kernarg_segment_ptr(); asm volatile("" : "+s"(kp_)); GAS unsigned char* wsl = (GAS unsigned char*)KARG(ucptr_t, 176); int lane = threadIdx.x & 63; asm volatile("" : "+v"(lane)); (void)lane
#define MOD ((float*)(GAS float*)(wsl + WS_MOD))
#define ROPE ((float*)(GAS float*)(wsl + WS_ROPE))
#define LAM ((float*)(GAS float*)(wsl + WS_LAM))
#define WIE ((bf16*)(GAS bf16*)(wsl + WS_WIE))
#define WOE ((bf16*)(GAS bf16*)(wsl + WS_WOE))
#define WIO ((bf16*)(GAS bf16*)(wsl + WS_WIO))
#define WOO ((bf16*)(GAS bf16*)(wsl + WS_WOO))
#define WQ ((bf16*)(GAS bf16*)(wsl + WS_WQ))
#define KEYS ((bf16*)(GAS bf16*)(wsl + WS_KEYS))
#define UB ((bf16*)(GAS bf16*)(wsl + WS_U))
#define VB ((bf16*)(GAS bf16*)(wsl + WS_V))
#define X ((bf16*)(GAS bf16*)(wsl + WS_X))
#define H ((bf16*)(GAS bf16*)(wsl + WS_H))
#define P ((bf16*)(GAS bf16*)(wsl + WS_P))
#define O ((bf16*)(GAS bf16*)(wsl + WS_O))
#define PQ ((bf16*)(GAS bf16*)(wsl + WS_P))
#define IDX ((int*)(GAS int*)(wsl + WS_IDX))
#define GATE ((float*)(GAS float*)(wsl + WS_GATE))
    const int lo = args.ph_lo, hi = args.ph_hi;
    unsigned long long probe_acc = 0;
    const int lane = F.lane, wave = F.wave, tid = F.tid, G = F.G, vcu = F.vcu;
    const int gw = vcu * NWAVES + wave, NGW = G * NWAVES;
#define IN(k) (lo <= (k) && (k) < hi)
#define SEAM(k) do { if (IN(k) && IN((k) + 1)) xcd_barrier(bar); } while (0)
#define KPROBE_ON (MK_PROBE != 0 && blockIdx.x == 0 && wave == 0)
#define KP_BEGIN(id) unsigned long long kp_##id = 0; if (MK_PROBE == (id) && KPROBE_ON) kp_##id = __builtin_readcyclecounter();
#define KP_END(id) if (MK_PROBE == (id) && KPROBE_ON) probe_acc += __builtin_readcyclecounter() - kp_##id;

    { KP_BEGIN(18)
    if (KIND_EN(8) && IN(0)) { WSL;
        LAS float* scr = (LAS float*)(F.lds + wave * 16384);
        constexpr int I_IE = 16 * 96, I_OE = 16 * 32, I_IO = 16 * 48, I_OO = 16 * 32, I_WQ = 16 * 64;
        constexpr int NIT = 2 * I_IE + 2 * I_OE + 2 * I_IO + 2 * I_OO + 4 * I_WQ;
        KP_BEGIN(31)
        for (int it = gw; it < NIT; it += NGW) {
            int r = it;
            if (r < 2 * I_IE) { const int j = r / I_IE; p0_transpose_item(INP(IN_WIE) + (size_t)j * 1024 * 3072, 1024, 3072, WIE + (size_t)j * 3072 * 1024, scr, r % I_IE, lane); continue; } r -= 2 * I_IE;
            if (r < 2 * I_OE) { const int j = r / I_OE; p0_transpose_item(INP(IN_WOE) + (size_t)j * 1024 * 1024, 1024, 1024, WOE + (size_t)j * 1024 * 1024, scr, r % I_OE, lane); continue; } r -= 2 * I_OE;
            if (r < 2 * I_IO) { const int j = r / I_IO; p0_transpose_item(INP(IN_WIO) + (size_t)j * 1024 * 1536, 1024, 1536, WIO + (size_t)j * 1536 * 1024, scr, r % I_IO, lane); continue; } r -= 2 * I_IO;
            if (r < 2 * I_OO) { const int j = r / I_OO; p0_transpose_item(INP(IN_WOO) + (size_t)j * 1024 * 1024, 1024, 1024, WOO + (size_t)j * 1024 * 1024, scr, r % I_OO, lane); continue; } r -= 2 * I_OO;
            { const int j = r / I_WQ; p0_transpose_item(INP(IN_WQ) + (size_t)j * 1024 * 2048, 1024, 2048, WQ + (size_t)j * 2048 * 1024, scr, r % I_WQ, lane); }
        }
        KP_END(31)
        KP_BEGIN(32)
        const size_t gtid = (size_t)vcu * 512 + tid, nthr = (size_t)G * 512;
        cvt_copy(INP(IN_KEYS), KEYS, (size_t)DEPTH * 8 * 2 * 128 * 128 / 8, gtid, nthr);
        cvt_fp4(INP(IN_U), INP(IN_V), (unsigned char*)UB, (size_t)DEPTH * NEXP * DM / 16, peer::U4_SCALE, peer::V4_SCALE, gtid, nthr);
        for (size_t i = gtid; i < 320 * 16; i += nthr) {
            const int pos = (int)(i >> 4), jf = (int)(i & 15); const int pp = pos < 256 ? pos : pos - 256;
            const float inv = powf(10000.f, -(float)jf / 16.f), ang = (float)pp * inv;
            ROPE[i * 2] = cosf(ang); ROPE[i * 2 + 1] = sinf(ang);
        }
        if (gtid < 2) {
            const float* lp = INP(IN_DLAM) + gtid * 256; float s1 = 0.f, s2 = 0.f;
            for (int k = 0; k < 64; ++k) { s1 += lp[k] * lp[64 + k]; s2 += lp[128 + k] * lp[192 + k]; }
            LAM[gtid] = expf(s1) - expf(s2) + (0.8f - 0.6f * expf(-0.3f * (float)(2 * gtid)));
        }
        KP_END(32)
        KP_BEGIN(33)
        __syncthreads();
        LAS float* sv = (LAS float*)F.lds; LAS float* red = (LAS float*)(F.lds + 12288);
        for (int i = tid; i < 3072; i += 512) { const int r = i >> 10, k = i & 1023; sv[i] = silu_f(r < 2 ? INP(IN_C)[r * 1024 + k] : INP(IN_CCTX)[k]); }
        __syncthreads();
        for (int it = vcu; it < DEPTH * 96; it += G) {
            const int L = it / 96, n0 = (it % 96) * 64;
            const float* wm = INP(IN_WMOD) + (size_t)L * 1024 * 6144 + n0 + lane;
            float a0 = 0.f, a1 = 0.f, a2 = 0.f;
#pragma unroll 8
            for (int k = wave * 128; k < wave * 128 + 128; ++k) { const float wv = wm[(size_t)k * 6144]; a0 += sv[k] * wv; a1 += sv[1024 + k] * wv; a2 += sv[2048 + k] * wv; }
            red[(wave * 3 + 0) * 64 + lane] = a0; red[(wave * 3 + 1) * 64 + lane] = a1; red[(wave * 3 + 2) * 64 + lane] = a2;
            __syncthreads();
            if (tid < 192) { const int r = tid >> 6, l = tid & 63; float s = 0.f;
#pragma unroll
                for (int w8 = 0; w8 < 8; ++w8) s += red[(w8 * 3 + r) * 64 + l];
                MOD[((size_t)L * 3 + r) * 6144 + n0 + l] = s + INP(IN_BMOD)[L * 6144 + n0 + l]; }
            __syncthreads();
        }
        KP_END(33)
    }
    KP_END(18) }
    { KP_BEGIN(28)
    SEAM(0);
    KP_END(28) }

    for (int L = 0; L < DEPTH; ++L) {
        unsigned long long kp_L = 0; if (MK_PROBE == 60 + L && KPROBE_ON) kp_L = __builtin_readcyclecounter();
        const int pb = 1 + 8 * L;
        const bool odd = (L & 1) != 0, last = (L == DEPTH - 1); const int j = L >> 1;
#define modL (MOD + (size_t)L * 3 * 6144)
        const int MR = last ? TL : TA;
        { KP_BEGIN(10)
        if (KIND_EN(0) && L == 0 && IN(pb)) { WSL;
            for (int row = gw; row < TA; row += NGW) {
                const bool lat = row < TL; const float* xr = lat ? INP(IN_X) + (size_t)row * DM : INP(IN_CTX) + (size_t)(row - TL) * DM;
                const float* mr = modL + (size_t)(lat ? (row >> 14) : 2) * 6144;
                norm_row<0>(xr, INP(IN_N1G) + L * DM, mr + 1024, mr, H + (size_t)row * DM, nullptr, lane);
            }
        }
        KP_END(10) }
        { KP_BEGIN(20)
        if (L == 0) SEAM(pb);
        KP_END(20) }
        { KP_BEGIN(11)
        if (KIND_EN(1) && IN(pb + 1)) { WSL;
            const int N = odd ? ODD_IN : EVEN_IN;
            if (MK_SKIP) { const size_t gtid = (size_t)vcu * 512 + threadIdx.x, nthr = (size_t)G * 512;
                for (size_t i = gtid; i < (size_t)TA * DM / 8; i += nthr) ((v4u*)O)[i] = (v4u){0u, 0u, 0u, 0u}; }
            pg8::Gemm g{H, odd ? WIO + (size_t)j * ODD_IN * DM : WIE + (size_t)j * EVEN_IN * DM, TA, N, DM}; pg8::StaticOrder S; S.init(TA, N, G, (int)blockIdx.x);
            pg8::EpiProj E{P, N, odd ? 1 : 0, ROPE, C2};
            for (int rep = 0; rep < ((MK_REPEAT & 2) ? 2 : 1); ++rep)
            pg8::gemm_phase<pg8::EpiProj, pg8::StaticOrder, true, true>(F.lds + RING_OFF, g, S, E);
        }
        KP_END(11) }
        { KP_BEGIN(21)
        SEAM(pb + 1);
        KP_END(21) }
        { KP_BEGIN(12)
        if (KIND_EN(2) && IN(pb + 2)) { WSL;
            if (!odd) {
                const float lam = LAM[j], osc = 1.f - (0.8f - 0.6f * expf(-0.3f * (float)L));
                const float* subg = INP(IN_SUBG) + j * 128; const float* rpb = INP(IN_RPB) + (size_t)j * 8 * 465;
                { KP_BEGIN(41)
                for (int rep = 0; rep < ((MK_REPEAT & 4) ? 2 : 1); ++rep)
                if (!(MK_SKIP & 1)) for (int u = vcu; u < 1024; u += G) { const int pair = (u & 255) >> 5, qb = (u & 31) + 32 * (u >> 8); att::diff_unit(false, pair >> 2, pair & 3, qb, P, O, lam, osc, subg, F.lds, probe_acc); }
                KP_END(41) }
                { KP_BEGIN(42)
                for (int rep = 0; rep < ((MK_REPEAT & 1024) ? 2 : 1); ++rep)
                if (!(MK_SKIP & 2)) for (int u = vcu; u < 1024; u += G) { const int pair = (u & 255) >> 4, g4 = (u & 15) + 16 * (u >> 8); att::na_unit(false, pair >> 3, pair & 7, g4, P, O, rpb, F.lds); }
                KP_END(42) }
                if (!last) for (int u = vcu; u < 256; u += G) if ((u & 7) == 0) { const int k = u >> 3;
                    if (k < 16) { if (!(MK_SKIP & 1)) att::diff_unit(true, k >> 3, (k >> 1) & 3, k & 1, P, O, lam, osc, subg, F.lds, probe_acc); }
                    else { if (!(MK_SKIP & 2)) att::na_unit(true, (k - 16) >> 3, (k - 16) & 7, 0, P, O, rpb, F.lds); } }
            } else {
                const float* sink = INP(IN_SINK) + j * 16;
                if (!(MK_SKIP & 4)) {
                { KP_BEGIN(43)
                for (int rep = 0; rep < ((MK_REPEAT & 2048) ? 2 : 1); ++rep)
                for (int u = vcu; u < 2048; u += G) { const int pair = (u & 255) >> 5, qb = (u & 31) + 32 * (u >> 8); att::swa_unit(false, pair >> 2, pair & 3, qb, P, O, sink, F.lds); }
                KP_END(43) }
                if (!last) for (int u = vcu; u < 256; u += G) if ((u & 7) == 0) { const int k = u >> 3; att::swa_unit(true, k >> 4, (k >> 2) & 3, k & 3, P, O, sink, F.lds); }
                }
            }
        }
        KP_END(12) }
        { KP_BEGIN(22)
        SEAM(pb + 2);
        KP_END(22) }
        { KP_BEGIN(13)
        if (KIND_EN(3) && IN(pb + 3)) { WSL;
            pg8::Gemm g{O, odd ? WOO + (size_t)j * DM * DM : WOE + (size_t)j * DM * DM, MR, DM, DM}; pg8::StaticOrder S; S.init(MR, DM, G, (int)blockIdx.x);
            pg8::EpiResid E{L == 0 ? INP(IN_X) : nullptr, L == 0 ? INP(IN_CTX) : nullptr, X, X, modL + 2048};
            pg8::gemm_phase<pg8::EpiResid, pg8::StaticOrder, true, true>(F.lds + RING_OFF, g, S, E);
        }
        KP_END(13) }
        { KP_BEGIN(23)
        SEAM(pb + 3);
        KP_END(23) }
        { KP_BEGIN(14)
        if (KIND_EN(4) && IN(pb + 4)) { WSL;
            for (int row = gw; row < MR; row += 2 * NGW) {
                const int rowb = row + NGW;
                const float* ma = modL + (size_t)(row < TL ? (row >> 14) : 2) * 6144;
                if (rowb < MR) { const float* mb = modL + (size_t)(rowb < TL ? (rowb >> 14) : 2) * 6144;
                    norm_row_x2(X + (size_t)row * DM, X + (size_t)rowb * DM, INP(IN_N2G) + L * DM, ma + 4096, ma + 3072, mb + 4096, mb + 3072, H + (size_t)row * DM, H + (size_t)rowb * DM, lane); }
                else norm_row<0, true>(X + (size_t)row * DM, INP(IN_N2G) + L * DM, ma + 4096, ma + 3072, H + (size_t)row * DM, nullptr, lane);
            }
        }
        KP_END(14) }
        { KP_BEGIN(24)
        SEAM(pb + 4);
        KP_END(24) }
        { KP_BEGIN(15)
        if (KIND_EN(5) && IN(pb + 5)) { WSL;
            pg8::Gemm g{H, WQ + (size_t)L * PQ_N * DM, MR, PQ_N, DM}; pg8::StaticOrder S; S.init(MR, PQ_N, G, (int)blockIdx.x);
            pg8::EpiProj E{PQ, PQ_N, 2, ROPE, 1.f};
            pg8::gemm_phase<pg8::EpiProj, pg8::StaticOrder, true, true>(F.lds + RING_OFF, g, S, E);
        }
        KP_END(15) }
        { KP_BEGIN(25)
        SEAM(pb + 5);
        KP_END(25) }
        { KP_BEGIN(16)
        if (KIND_EN(6) && IN(pb + 6)) { WSL;
            const int nunits = 8 * (MR / 256); int cur_h = -1;
            int tid = threadIdx.x; asm volatile("" : "+v"(tid));
            for (int rep = 0; rep < ((MK_REPEAT & 64) ? 2 : 1); ++rep)
            for (int u = vcu; u < nunits; u += G) {
                int h, cb; if (u < 1024) { h = (u & 255) >> 5; cb = (u & 31) + 32 * (u >> 8); } else { h = (u - 1024) >> 1; cb = 128 + ((u - 1024) & 1); }
                if (h != cur_h) {
                    __syncthreads();
                    const bf16* kg = KEYS + (size_t)(L * 8 + h) * 2 * 128 * 128;
                    for (int c = tid; c < 4096; c += 512) { const int p = c >> 11, row = (c >> 4) & 127, ch = c & 15;
                        *(LAS v4u*)(F.lds + peer::L_KEYS + p * peer::KEYIMG + row * peer::KEYROWB + ch * 16) = *(const v4u*)(kg + (size_t)(p * 128 + row) * 128 + ch * 8); }
                    __syncthreads(); cur_h = h;
                }
                peer::topk_wave(PQ, (size_t)cb * 256 + wave * 32, h, F.lds + peer::L_KEYS, (LAS unsigned*)(F.lds + peer::L_TAB) + wave * 512, IDX, GATE, lane);
            }
        }
        KP_END(16) }
        { KP_BEGIN(26)
        SEAM(pb + 6);
        KP_END(26) }
        { KP_BEGIN(17)
        if (KIND_EN(7) && IN(pb + 7)) { WSL;
            const unsigned char* Ul = (const unsigned char*)UB + (size_t)L * NEXP * DM; const unsigned char* Vl = (const unsigned char*)VB + (size_t)L * NEXP * DM;
#define EXPERT_FINISH(FF, tt) do { const int t = (tt); \
                const float* g2 = modL + (size_t)(t < TL ? (t >> 14) : 2) * 6144 + 5120 + 16 * lane; \
                bf16* xr = X + (size_t)t * DM + 16 * lane; \
                const v4u xw0 = *(const v4u*)xr, xw1 = *(const v4u*)(xr + 8); const unsigned xw[8] = {xw0.x, xw0.y, xw0.z, xw0.w, xw1.x, xw1.y, xw1.z, xw1.w}; \
                f32x4 xn[4]; float ss = 0.f; unsigned xo[8]; \
                _Pragma("unroll") for (int c = 0; c < 4; ++c) { \
                    f32x4 xa = (f32x4){__uint_as_float(xw[2 * c] << 16), __uint_as_float(xw[2 * c] & 0xffff0000u), __uint_as_float(xw[2 * c + 1] << 16), __uint_as_float(xw[2 * c + 1] & 0xffff0000u)}; \
                    const f32x4 ga = *(const f32x4*)(g2 + 4 * c); \
                    xa += ga * (f32x4){FF[2 * c].x, FF[2 * c].y, FF[2 * c + 1].x, FF[2 * c + 1].y}; \
                    xo[2 * c] = pk2(xa.x, xa.y); xo[2 * c + 1] = pk2(xa.z, xa.w); \
                    xn[c] = xa; ss += (xa.x * xa.x + xa.y * xa.y) + (xa.z * xa.z + xa.w * xa.w); } \
                if (!last) { *(v4u*)xr = (v4u){xo[0], xo[1], xo[2], xo[3]}; *(v4u*)(xr + 8) = (v4u){xo[4], xo[5], xo[6], xo[7]}; } \
                const float rstd = __builtin_amdgcn_rsqf(wave_sum(ss) * (1.f / DM) + EPS); \
                if (!last) { \
                    const float* mn = MOD + (size_t)(L + 1) * 3 * 6144 + (size_t)(t < TL ? (t >> 14) : 2) * 6144 + 16 * lane; \
                    const float* gn = INP(IN_N1G) + (L + 1) * DM + 16 * lane; \
                    unsigned ow[8]; \
                    _Pragma("unroll") for (int c = 0; c < 4; ++c) { \
                        const f32x4 y = xn[c] * rstd * *(const f32x4*)(gn + 4 * c) * (*(const f32x4*)(mn + 1024 + 4 * c) + 1.f) + *(const f32x4*)(mn + 4 * c); \
                        ow[2 * c] = pk2(y.x, y.y); ow[2 * c + 1] = pk2(y.z, y.w); } \
                    bf16* hr = H + (size_t)t * DM + 16 * lane; *(v4u*)hr = (v4u){ow[0], ow[1], ow[2], ow[3]}; *(v4u*)(hr + 8) = (v4u){ow[4], ow[5], ow[6], ow[7]}; \
                } else { \
                    const float* fg = INP(IN_FG) + 16 * lane; float* orow = (float*)(GAS float*)KARG(fptr_t, 168) + (size_t)t * DM + 16 * lane; \
                    _Pragma("unroll") for (int c = 0; c < 4; ++c) *(f32x4*)(orow + 4 * c) = xn[c] * rstd * *(const f32x4*)(fg + 4 * c); } \
                __builtin_amdgcn_sched_barrier(0);     \
            } while (0)
            const unsigned char* UV6 = (const unsigned char*)UB + (size_t)L * NEXP * 64 * 16;
            const int lane_p = lane;
            for (int t1 = gw; t1 < MR; t1 += NGW) {
                peer::f2 f[8];
                { int lane = lane_p; asm volatile("" : "+v"(lane));
                  peer::expert_token4(H + (size_t)t1 * DM, IDX + (size_t)t1 * 128, GATE + (size_t)t1 * 128, UV6, f, lane); }
                { int lane = lane_p; asm volatile("" : "+v"(lane)); EXPERT_FINISH(f, t1); }
            }
#undef EXPERT_FINISH
        }
        KP_END(17) }
        { KP_BEGIN(27)
        if (!last) SEAM(pb + 7);
        KP_END(27) }
        if (MK_PROBE == 60 + L && KPROBE_ON) probe_acc += __builtin_readcyclecounter() - kp_L;
    }
    if (MK_PROBE != 0) { KP_BEGIN(29) xcd_barrier(bar); KP_END(29) }
    if (MK_PROBE != 0 && blockIdx.x == 0 && wave == 0) { const unsigned long long t0 = __builtin_readcyclecounter(); while (__builtin_readcyclecounter() - t0 < probe_acc) __builtin_amdgcn_s_sleep(8); }
#undef IN
#undef SEAM
}

extern "C" void kernel_launch(void* const* d_in, const int* in_sizes, int n_in, void* d_out, int out_size, void* d_ws, size_t ws_size, hipStream_t stream) {
    static int grid = 0;
    if (grid == 0) {
        if (n_in != 21 || in_sizes[0] != TL * DM || out_size != TL * DM || ws_size < WS_END) {
            fprintf(stderr, "kernel_launch: unexpected shapes (n_in %d, in0 %d, out %d, ws %zu); nothing launched\n", n_in, n_in > 0 ? in_sizes[0] : -1, out_size, ws_size); grid = -1; return; }
        int dev = 0, cus = 0, per_cu = 0;
        if (hipGetDevice(&dev) != hipSuccess || hipDeviceGetAttribute(&cus, hipDeviceAttributeMultiprocessorCount, dev) != hipSuccess) { fprintf(stderr, "kernel_launch: device query failed\n"); grid = -1; return; }
        if (hipFuncSetAttribute((const void*)fwd, hipFuncAttributeMaxDynamicSharedMemorySize, LDS_BYTES) != hipSuccess) { fprintf(stderr, "kernel_launch: hipFuncSetAttribute failed\n"); grid = -1; return; }
        if (hipOccupancyMaxActiveBlocksPerMultiprocessor(&per_cu, (const void*)fwd, NWAVES * 64, LDS_BYTES) != hipSuccess || per_cu < 1)
            fprintf(stderr, "kernel_launch: note: occupancy query reports %d workgroups per CU\n", per_cu);
        (void)hipGetLastError();
        grid = cus;
    }
    if (grid < 0) return;
    if (hipMemsetAsync((char*)d_ws + WS_CTL, 0, CTL_ZERO_BYTES, stream) != hipSuccess) { fprintf(stderr, "kernel_launch: memset failed\n"); return; }
    Args a{};
    for (int i = 0; i < 21; ++i) a.in[i] = (const float*)d_in[i];
    a.out = (float*)d_out; a.ws = (unsigned char*)d_ws;
#if MK_PER_PHASE
    for (int p = 0; p < NPHASES; ++p) { a.ph_lo = p; a.ph_hi = p + 1; hipLaunchKernelGGL(fwd, dim3(grid), dim3(NWAVES * 64), LDS_BYTES, stream, a); }
#else
    a.ph_lo = 0; a.ph_hi = NPHASES;
    hipLaunchKernelGGL(fwd, dim3(grid), dim3(NWAVES * 64), LDS_BYTES, stream, a);
#endif
    const hipError_t le = hipPeekAtLastError();
    if (le != hipSuccess) fprintf(stderr, "kernel_launch: launch failed: %s\n", hipGetErrorName(le));
}
```
